# Optimizing an MI355X kernel written in HIP

```python
import jax
import jax.numpy as jnp
from jax import lax
import numpy as np

D_MODEL = 1024
BATCH = 8
SEQ = 2048
DEPTH = 2

D_MIX = D_MODEL
N_MIXERS = 4
GROUP_W = D_MIX // N_MIXERS
HEAD_DIM = 64
GROUP_HEADS = GROUP_W // HEAD_DIM
D_FF = 256 * ((8 * D_MODEL // 3 + 255) // 256)
ALPHA = (2.0 * DEPTH) ** 0.25
BETA = (8.0 * DEPTH) ** -0.25
MLA_HEADS = GROUP_HEADS
MLA_NOPE = HEAD_DIM
MLA_ROPE = HEAD_DIM // 2
MLA_V = GROUP_W // MLA_HEADS
Q_LORA = D_MODEL // 4
KV_LORA = D_MODEL // 8
ROPE_THETA = 10000.0
Q_BLOCK = 128
LRU_HEADS = GROUP_HEADS
LRU_BLOCK = GROUP_W // LRU_HEADS
CONV_W = 4
LRU_C = 8.0
SWA_HEADS = GROUP_HEADS
DILATED_PATTERNS = ((128, 1), (512, 4), (2048, 16))
ML_HEADS = GROUP_HEADS
ML_CHUNK = 64
IN_SIZES = (Q_LORA, KV_LORA, MLA_ROPE, GROUP_W, GROUP_W, GROUP_W, GROUP_W, GROUP_W, GROUP_W, GROUP_W, GROUP_W, GROUP_W, ML_HEADS, ML_HEADS)
N_IN = sum(IN_SIZES)

kernel_name = 'hybrid_parallel_mla_rglru_dilated_mlstm_macaron'


def _layernorm(x, g, b, eps=1e-5):
    xf = x.astype(jnp.float32)
    mu = jnp.mean(xf, axis=-1, keepdims=True)
    var = jnp.mean(jnp.square(xf - mu), axis=-1, keepdims=True)
    return ((xf - mu) * lax.rsqrt(var + eps) * g + b).astype(x.dtype)


def _rmsnorm(x, g, eps=1e-6):
    xf = x.astype(jnp.float32)
    return (xf * lax.rsqrt(jnp.mean(xf * xf, axis=-1, keepdims=True) + eps) * g).astype(x.dtype)


def _group_rmsnorm(y, g, eps=1e-6):
    B, S, _ = y.shape
    yf = y.astype(jnp.float32).reshape(B, S, N_MIXERS, GROUP_W)
    yf = yf * lax.rsqrt(jnp.mean(yf * yf, axis=-1, keepdims=True) + eps)
    return (yf.reshape(B, S, D_MIX) * g).astype(y.dtype)


def _swiglu(x, w1, w3, w2):
    return (jax.nn.silu(x @ w1) * (x @ w3)) @ w2


def _split_columns(z):
    parts, start = [], 0
    for size in IN_SIZES:
        parts.append(z[..., start:start + size])
        start += size
    return parts


def _rope(x, pos):
    half = x.shape[-1] // 2
    freqs = ROPE_THETA ** (-jnp.arange(half, dtype=jnp.float32) / half)
    ang = pos.astype(jnp.float32)[:, None] * freqs[None, :]
    cos, sin = jnp.cos(ang)[:, None, :], jnp.sin(ang)[:, None, :]
    x1, x2 = x[..., :half].astype(jnp.float32), x[..., half:].astype(jnp.float32)
    return jnp.concatenate([x1 * cos - x2 * sin, x1 * sin + x2 * cos], axis=-1).astype(x.dtype)


def _causal_block_attention(q, k, v, scale):
    B, S, H, E = q.shape
    nb = S // Q_BLOCK
    qb = jnp.moveaxis(q.reshape(B, nb, Q_BLOCK, H, E), 1, 0)
    kpos = jnp.arange(S)

    def one_block(args):
        qi, i = args
        s = jnp.einsum('bqhe,bkhe->bhqk', qi, k, preferred_element_type=jnp.float32) * scale
        qpos = i * Q_BLOCK + jnp.arange(Q_BLOCK)
        s = jnp.where(kpos[None, :] <= qpos[:, None], s, -jnp.inf)
        p = jax.nn.softmax(s, axis=-1)
        return jnp.einsum('bhqk,bkhe->bqhe', p.astype(v.dtype), v)

    out = lax.map(one_block, (qb, jnp.arange(nb)))
    return jnp.moveaxis(out, 0, 1).reshape(B, S, H, v.shape[-1])


def _mla(c_q, c_kv, k_rope, q_norm, kv_norm, w_uq, w_ukv):
    B, S, _ = c_q.shape
    pos = jnp.arange(S)
    q = (_rmsnorm(c_q, q_norm) @ w_uq).reshape(B, S, MLA_HEADS, MLA_NOPE + MLA_ROPE)
    kv = (_rmsnorm(c_kv, kv_norm) @ w_ukv).reshape(B, S, MLA_HEADS, MLA_NOPE + MLA_V)
    q = jnp.concatenate([q[..., :MLA_NOPE], _rope(q[..., MLA_NOPE:], pos)], axis=-1)
    k_r = jnp.broadcast_to(_rope(k_rope[:, :, None, :], pos), (B, S, MLA_HEADS, MLA_ROPE))
    k = jnp.concatenate([kv[..., :MLA_NOPE], k_r], axis=-1)
    v = kv[..., MLA_NOPE:]
    o = _causal_block_attention(q, k, v, (MLA_NOPE + MLA_ROPE) ** -0.5)
    return o.reshape(B, S, MLA_HEADS * MLA_V)


def _rglru(xb, gate, conv_w, conv_b, w_a, b_a, w_x, b_x, lam):
    B, S, W = xb.shape
    xc = lax.conv_general_dilated(xb, conv_w[:, None, :], window_strides=(1,), padding=((CONV_W - 1, 0),),
                                  dimension_numbers=('NWC', 'WIO', 'NWC'), feature_group_count=W) + conv_b
    xh = xc.reshape(B, S, LRU_HEADS, LRU_BLOCK)
    r = jax.nn.sigmoid(jnp.einsum('bshi,hij->bshj', xh, w_a).reshape(B, S, W) + b_a)
    i = jax.nn.sigmoid(jnp.einsum('bshi,hij->bshj', xh, w_x).reshape(B, S, W) + b_x)
    log_a = -LRU_C * r.astype(jnp.float32) * jax.nn.softplus(-lam.astype(jnp.float32))
    a = jnp.exp(log_a)
    u = jnp.sqrt(-jnp.expm1(2.0 * log_a)) * (i * xc).astype(jnp.float32)

    def combine(left, right):
        a1, b1 = left
        a2, b2 = right
        return a1 * a2, a2 * b1 + b2

    _, h = lax.associative_scan(combine, (a, u), axis=1)
    return (h * jax.nn.gelu(gate.astype(jnp.float32))).astype(xb.dtype)


def _band_attention(q, k, v, back):
    N, L, H, E = q.shape
    blk = back
    nb = -(-L // blk)
    pad = nb * blk - L
    padf = lambda t: jnp.pad(t, ((0, 0), (0, pad), (0, 0), (0, 0))).reshape(N, nb, blk, H, E)
    qb, kb, vb = padf(q), padf(k), padf(v)

    def with_prev(t):
        prev = jnp.concatenate([jnp.zeros_like(t[:, :1]), t[:, :-1]], axis=1)
        return jnp.concatenate([prev, t], axis=2)

    kk, vv = with_prev(kb), with_prev(vb)
    s = jnp.einsum('nbqhe,nbkhe->nbhqk', qb, kk, preferred_element_type=jnp.float32) * (E ** -0.5)
    a_idx = jnp.arange(blk)[:, None]
    c_idx = jnp.arange(2 * blk)[None, :]
    rel = a_idx + blk - c_idx
    blk_id = jnp.arange(nb)[:, None, None]
    mask = (rel >= 0) & (rel <= back) & ((blk_id > 0) | (c_idx >= blk))
    s = jnp.where(mask[None, :, None], s, -jnp.inf)
    m = jnp.max(s, axis=-1, keepdims=True)
    p = jnp.exp(s - m)
    l = jnp.sum(p, axis=-1, keepdims=True)
    o = jnp.einsum('nbhqk,nbkhe->nbqhe', p / l, vv.astype(jnp.float32))
    lse = (m + jnp.log(l))[..., 0]
    o = o.reshape(N, nb * blk, H, E)[:, :L]
    lse = lse.transpose(0, 1, 3, 2).reshape(N, nb * blk, H)[:, :L]
    return o, lse


def _dilated_attention(q, k, v):
    B, S, H, E = q.shape
    outs, lses = [], []
    for window, dil in DILATED_PATTERNS:
        L = S // dil
        fold = lambda t: t.reshape(B, L, dil, H, E).transpose(0, 2, 1, 3, 4).reshape(B * dil, L, H, E)
        o, lse = _band_attention(fold(q), fold(k), fold(v), window // dil)
        outs.append(o.reshape(B, dil, L, H, E).transpose(0, 2, 1, 3, 4).reshape(B, S, H, E))
        lses.append(lse.reshape(B, dil, L, H).transpose(0, 2, 1, 3).reshape(B, S, H))
    wts = jax.nn.softmax(jnp.stack(lses), axis=0)
    return jnp.einsum('pbsh,pbshe->bshe', wts, jnp.stack(outs)).astype(q.dtype)


def _mlstm_chunkwise(q, k, v, log_i, log_f):
    B, S, H, E = q.shape
    nc = S // ML_CHUNK

    def chunks(t):
        return jnp.moveaxis(t.reshape((B, nc, ML_CHUNK) + t.shape[2:]), 1, 0)

    tri = jnp.tril(jnp.ones((ML_CHUNK, ML_CHUNK), dtype=bool))[None, :, :, None]

    def step(carry, inp):
        C, n, m = carry
        qc, kc, vc, ic, fc = inp
        b = jnp.cumsum(fc, axis=1)
        g = b[:, -1]
        D = jnp.where(tri, b[:, :, None, :] - b[:, None, :, :] + ic[:, None, :, :], -jnp.inf)
        inter = b + m[:, None, :]
        mt = jnp.maximum(jnp.max(D, axis=2), inter)
        s = jnp.einsum('bthe,bshe->btsh', qc, kc) * jnp.exp(D - mt[:, :, None, :])
        w_inter = jnp.exp(inter - mt)
        num = jnp.einsum('btsh,bshe->bthe', s, vc) + w_inter[..., None] * jnp.einsum('bthe,bhef->bthf', qc, C)
        den = jnp.sum(s, axis=2) + w_inter * jnp.einsum('bthe,bhe->bth', qc, n)
        h = num / jnp.maximum(jnp.abs(den), jnp.exp(-mt))[..., None]
        wk = g[:, None, :] - b + ic
        m_new = jnp.maximum(g + m, jnp.max(wk, axis=1))
        decay = jnp.exp(g + m - m_new)
        wk = jnp.exp(wk - m_new[:, None, :])
        C_new = decay[..., None, None] * C + jnp.einsum('bsh,bshe,bshf->bhef', wk, kc, vc)
        n_new = decay[..., None] * n + jnp.einsum('bsh,bshe->bhe', wk, kc)
        return (C_new, n_new, m_new), h

    init = (jnp.zeros((B, H, E, E), jnp.float32), jnp.zeros((B, H, E), jnp.float32), jnp.zeros((B, H), jnp.float32))
    _, hs = lax.scan(step, init, (chunks(q), chunks(k), chunks(v), chunks(log_i), chunks(log_f)))
    return jnp.moveaxis(hs, 0, 1).reshape(B, S, H, E)


def _mlstm(q, k, v, o_gate, ig, fg, b_i, b_f):
    B, S, _ = q.shape
    heads = lambda t: t.reshape(B, S, ML_HEADS, HEAD_DIM).astype(jnp.float32)
    log_i = ig.astype(jnp.float32) + b_i
    log_f = jax.nn.log_sigmoid(fg.astype(jnp.float32) + b_f)
    h = _mlstm_chunkwise(heads(q), heads(k) * (HEAD_DIM ** -0.5), heads(v), log_i, log_f)
    return (jax.nn.sigmoid(o_gate.astype(jnp.float32)) * h.reshape(B, S, GROUP_W)).astype(q.dtype)


def _token_mixing(x, w_in, mla_q_norm, mla_kv_norm, mla_w_uq, mla_w_ukv, lru_conv_w, lru_conv_b, lru_w_a,
                  lru_b_a, lru_w_x, lru_b_x, lru_lambda, ml_b_i, ml_b_f, out_norm, w_out):
    B, S, _ = x.shape
    (c_q, c_kv, k_rope, lru_x, lru_gate, sw_q, sw_k, sw_v,
     ml_q, ml_k, ml_v, ml_o, ml_i, ml_f) = _split_columns(x @ w_in)
    heads = lambda t: t.reshape(B, S, SWA_HEADS, HEAD_DIM)
    y_a = _mla(c_q, c_kv, k_rope, mla_q_norm, mla_kv_norm, mla_w_uq, mla_w_ukv)
    y_b = _rglru(lru_x, lru_gate, lru_conv_w, lru_conv_b, lru_w_a, lru_b_a, lru_w_x, lru_b_x, lru_lambda)
    y_c = _dilated_attention(heads(sw_q), heads(sw_k), heads(sw_v)).reshape(B, S, GROUP_W)
    y_d = _mlstm(ml_q, ml_k, ml_v, ml_o, ml_i, ml_f, ml_b_i, ml_b_f)
    y = _group_rmsnorm(jnp.concatenate([y_a, y_b, y_c, y_d], axis=-1), out_norm)
    return y @ w_out


def setup_inputs(seed: int = 0) -> dict:
    key = jax.random.key(seed)
    ks = jax.random.split(key, 24)
    f32 = jnp.float32
    nrm = lambda k, shape, scale: jax.random.normal(k, shape, f32) * scale
    x = nrm(ks[0], (BATCH, SEQ, D_MODEL), 1.0)
    ln_g = 1.0 + nrm(ks[1], (DEPTH, 3, D_MODEL), 0.02)
    ln_b = nrm(ks[2], (DEPTH, 3, D_MODEL), 0.02)
    ffn_w1 = nrm(ks[3], (DEPTH, 2, D_MODEL, D_FF), D_MODEL ** -0.5)
    ffn_w3 = nrm(ks[4], (DEPTH, 2, D_MODEL, D_FF), D_MODEL ** -0.5)
    ffn_w2 = nrm(ks[5], (DEPTH, 2, D_FF, D_MODEL), D_FF ** -0.5 * BETA)
    w_in = nrm(ks[6], (DEPTH, D_MODEL, N_IN), D_MODEL ** -0.5)
    mla_q_norm = 1.0 + nrm(ks[7], (DEPTH, Q_LORA), 0.02)
    mla_kv_norm = 1.0 + nrm(ks[8], (DEPTH, KV_LORA), 0.02)
    mla_w_uq = nrm(ks[9], (DEPTH, Q_LORA, MLA_HEADS * (MLA_NOPE + MLA_ROPE)), Q_LORA ** -0.5)
    mla_w_ukv = nrm(ks[10], (DEPTH, KV_LORA, MLA_HEADS * (MLA_NOPE + MLA_V)), KV_LORA ** -0.5)
    lru_conv_w = nrm(ks[11], (DEPTH, CONV_W, GROUP_W), CONV_W ** -0.5)
    lru_conv_b = nrm(ks[12], (DEPTH, GROUP_W), 0.02)
    lru_w_a = nrm(ks[13], (DEPTH, LRU_HEADS, LRU_BLOCK, LRU_BLOCK), LRU_BLOCK ** -0.5)
    lru_b_a = nrm(ks[14], (DEPTH, GROUP_W), 0.02)
    lru_w_x = nrm(ks[15], (DEPTH, LRU_HEADS, LRU_BLOCK, LRU_BLOCK), LRU_BLOCK ** -0.5)
    lru_b_x = nrm(ks[16], (DEPTH, GROUP_W), 0.02)
    a0 = jax.random.uniform(ks[17], (DEPTH, GROUP_W), f32, 0.9, 0.999)
    s0 = a0 ** (1.0 / LRU_C)
    lru_lambda = jnp.log(s0) - jnp.log1p(-s0)
    ml_b_i = nrm(ks[18], (DEPTH, ML_HEADS), 0.1)
    ml_b_f = jnp.linspace(3.0, 6.0, ML_HEADS, dtype=f32)[None, :] + nrm(ks[19], (DEPTH, ML_HEADS), 0.02)
    out_norm = 1.0 + nrm(ks[20], (DEPTH, D_MIX), 0.02)
    w_out = nrm(ks[21], (DEPTH, D_MIX, D_MODEL), D_MIX ** -0.5 * BETA)
    return {'x': x, 'ln_g': ln_g, 'ln_b': ln_b, 'ffn_w1': ffn_w1, 'ffn_w3': ffn_w3, 'ffn_w2': ffn_w2,
            'w_in': w_in, 'mla_q_norm': mla_q_norm, 'mla_kv_norm': mla_kv_norm, 'mla_w_uq': mla_w_uq,
            'mla_w_ukv': mla_w_ukv, 'lru_conv_w': lru_conv_w, 'lru_conv_b': lru_conv_b, 'lru_w_a': lru_w_a,
            'lru_b_a': lru_b_a, 'lru_w_x': lru_w_x, 'lru_b_x': lru_b_x, 'lru_lambda': lru_lambda,
            'ml_b_i': ml_b_i, 'ml_b_f': ml_b_f, 'out_norm': out_norm, 'w_out': w_out}


def reference(x, ln_g, ln_b, ffn_w1, ffn_w3, ffn_w2, w_in, mla_q_norm, mla_kv_norm, mla_w_uq, mla_w_ukv,
              lru_conv_w, lru_conv_b, lru_w_a, lru_b_a, lru_w_x, lru_b_x, lru_lambda, ml_b_i, ml_b_f,
              out_norm, w_out):
    for l in range(DEPTH):
        x = _layernorm(ALPHA * x + 0.5 * _swiglu(x, ffn_w1[l, 0], ffn_w3[l, 0], ffn_w2[l, 0]), ln_g[l, 0], ln_b[l, 0])
        y = _token_mixing(x, w_in[l], mla_q_norm[l], mla_kv_norm[l], mla_w_uq[l], mla_w_ukv[l],
                          lru_conv_w[l], lru_conv_b[l], lru_w_a[l], lru_b_a[l], lru_w_x[l], lru_b_x[l],
                          lru_lambda[l], ml_b_i[l], ml_b_f[l], out_norm[l], w_out[l])
        x = _layernorm(ALPHA * x + y, ln_g[l, 1], ln_b[l, 1])
        x = _layernorm(ALPHA * x + 0.5 * _swiglu(x, ffn_w1[l, 1], ffn_w3[l, 1], ffn_w2[l, 1]), ln_g[l, 2], ln_b[l, 2])
    return x
```

```cpp
#ifndef EMU
#include <hip/hip_runtime.h>
#include <cstdio>
#include <cstdint>
#include <cmath>
#define DEV __device__ __forceinline__
#else
#define DEV static inline
#endif

#ifndef CFG_B
#define CFG_B 8
#endif
#ifndef CFG_S
#define CFG_S 2048
#endif
#ifndef MK_N_LAUNCHES
#define MK_N_LAUNCHES 1
#endif

typedef short bf16x8 __attribute__((ext_vector_type(8)));
typedef short bf16x4 __attribute__((ext_vector_type(4)));
typedef float f32x16 __attribute__((ext_vector_type(16)));
typedef float f32x4 __attribute__((ext_vector_type(4)));
typedef unsigned u32x4 __attribute__((ext_vector_type(4)));
typedef unsigned u32x2 __attribute__((ext_vector_type(2)));

constexpr int NB = CFG_B, SEQ = CFG_S, M = NB * SEQ, D = 1024, DFF = 2816, NIN = 2728, NINP = 2816, DEPTH = 2;
constexpr int NC = SEQ / 64, NLC = SEQ / 32, NQ = SEQ / 64;
constexpr float ALPHA = 1.41421356237309505f;
constexpr float LOG2E = 1.4426950408889634f;
constexpr int ZC_CQ = 0, ZC_CKV = 256, ZC_KR = 384, ZC_LX = 416, ZC_LG = 672, ZC_SQ = 928, ZC_SK = 1184, ZC_SV = 1440, ZC_MQ = 1696, ZC_MK = 1952, ZC_MV = 2208, ZC_MO = 2464, ZC_MI = 2720;
constexpr int PH_L0 = 1, PH_PER_LAYER = 12, NPHASES = 1 + DEPTH * PH_PER_LAYER;

constexpr size_t al256(size_t x) { return (x + 255) & ~(size_t)255; }
constexpr size_t CTL_BYTES = 1u << 20;
constexpr size_t SZ_W13 = (size_t)2 * DFF * D * 2, SZ_W2 = (size_t)D * DFF * 2, SZ_WIN = (size_t)NINP * D * 2, SZ_WOUT = (size_t)D * D * 2;
constexpr size_t SZ_WUQ = 384 * 256 * 2, SZ_WUKV = 512 * 128 * 2, SZ_WLRU = 4 * 64 * 64 * 2, SZ_ROPE = (size_t)SEQ * 16 * 4;
constexpr size_t WS_W13 = CTL_BYTES;
constexpr size_t WS_W2 = WS_W13 + 4 * SZ_W13;
constexpr size_t WS_WIN = WS_W2 + 4 * SZ_W2;
constexpr size_t WS_WOUT = WS_WIN + 2 * SZ_WIN;
constexpr size_t WS_WUQ = WS_WOUT + 2 * SZ_WOUT;
constexpr size_t WS_WUKV = WS_WUQ + 2 * SZ_WUQ;
constexpr size_t WS_WLRU = WS_WUKV + 2 * SZ_WUKV;
constexpr size_t WS_ROPE = WS_WLRU + 4 * SZ_WLRU;
constexpr size_t WS_XB = al256(WS_ROPE + 2 * SZ_ROPE);
constexpr size_t WS_HZ = WS_XB + (size_t)M * D * 2;
constexpr size_t WS_QM = WS_HZ + (size_t)M * NINP * 2;
constexpr size_t WS_KM = WS_QM + (size_t)M * 384 * 2;
constexpr size_t WS_VM = WS_KM + (size_t)M * 384 * 2;
constexpr size_t WS_GF = WS_VM + (size_t)M * 256 * 2;
constexpr size_t WS_CT = WS_GF + (size_t)M * 8 * 4;
constexpr size_t WS_NU = WS_CT + (size_t)NB * 4 * NC * 4096 * 4;
constexpr size_t WS_AG = WS_NU + (size_t)NB * 4 * NC * 64 * 4;
constexpr size_t WS_MS = WS_AG + (size_t)NB * 4 * NC * 2 * 4;
constexpr size_t WS_LAC = al256(WS_MS + (size_t)NB * 4 * NC * 4);
constexpr size_t WS_LHC = WS_LAC + (size_t)NB * NLC * 256 * 4;
constexpr size_t WS_LCR = WS_LHC + (size_t)NB * NLC * 256 * 4;
constexpr size_t WS_TOTAL = WS_LCR + (size_t)NB * NLC * 256 * 4;
static_assert(WS_TOTAL <= (size_t)256 * 1024 * 1024, "workspace map exceeds 256 MiB");

struct Params { const float* in[22]; float* out; unsigned char* ws; };
#ifndef UNIT_MASK
#define UNIT_MASK 0xFFFF
#endif
#define UM(k) ((UNIT_MASK >> (k)) & 1)

#ifndef EMU
extern __shared__ __attribute__((aligned(16))) unsigned char dyn_lds[];
DEV int tid() { int t = (int)threadIdx.x; asm volatile("" : "+v"(t)); return t; }
DEV int bid() { int b = (int)blockIdx.x; asm volatile("" : "+s"(b)); return b; }
DEV int nblk() { return (int)gridDim.x; }
DEV void bsync() { __syncthreads(); }
DEV void wsync() { asm volatile("s_waitcnt lgkmcnt(0)" ::: "memory"); }
DEV unsigned char* lds_base() { return dyn_lds; }
DEV f32x16 mfma32(bf16x8 a, bf16x8 b, f32x16 c) { return __builtin_amdgcn_mfma_f32_32x32x16_bf16(a, b, c, 0, 0, 0); }
DEV float shfl_xor(float v, int m) { return __shfl_xor(v, m); }
DEV float shfl_up(float v, int d) { return __shfl_up(v, d); }
DEV float shfl_idx(float v, int s) { return __shfl(v, s); }
DEV float ex2(float x) { return __builtin_amdgcn_exp2f(x); }
DEV float rcpf(float x) { return __builtin_amdgcn_rcpf(x); }
DEV float rsqf(float x) { return __builtin_amdgcn_rsqf(x); }
DEV float sin_rev(float x) { return __builtin_amdgcn_sinf(x); }
DEV float cos_rev(float x) { return __builtin_amdgcn_cosf(x); }
#endif

DEV unsigned short f2bf(float f) { unsigned u = __builtin_bit_cast(unsigned, f); u += 0x7fffu + ((u >> 16) & 1u); return (unsigned short)(u >> 16); }
DEV float bf2f(unsigned short h) { return __builtin_bit_cast(float, (unsigned)h << 16); }
DEV float bfs2f(short h) { return bf2f((unsigned short)h); }
DEV unsigned pk2(float lo, float hi) { return (unsigned)f2bf(lo) | ((unsigned)f2bf(hi) << 16); }
DEV int crow(int reg, int hi) { return (reg & 3) + 8 * (reg >> 2) + 4 * hi; }
DEV float sigmoidf_(float x) { return rcpf(1.0f + ex2(-x * LOG2E)); }
DEV float wave_sum(float v) {
#pragma unroll
    for (int o = 1; o < 64; o <<= 1) v += shfl_xor(v, o);
    return v;
}
DEV float wave_max(float v) {
#pragma unroll
    for (int o = 1; o < 64; o <<= 1) v = fmaxf(v, shfl_xor(v, o));
    return v;
}
DEV bf16x8 pack8(float a0, float a1, float a2, float a3, float a4, float a5, float a6, float a7) {
    u32x4 w; w.x = pk2(a0, a1); w.y = pk2(a2, a3); w.z = pk2(a4, a5); w.w = pk2(a6, a7); return __builtin_bit_cast(bf16x8, w);
}

DEV unsigned short* W13T(const Params& p, int l, int f) { return (unsigned short*)(p.ws + WS_W13 + (size_t)(l * 2 + f) * SZ_W13); }
DEV unsigned short* W2T(const Params& p, int l, int f) { return (unsigned short*)(p.ws + WS_W2 + (size_t)(l * 2 + f) * SZ_W2); }
DEV unsigned short* WINT(const Params& p, int l) { return (unsigned short*)(p.ws + WS_WIN + (size_t)l * SZ_WIN); }
DEV unsigned short* WOUTT(const Params& p, int l) { return (unsigned short*)(p.ws + WS_WOUT + (size_t)l * SZ_WOUT); }
DEV unsigned short* WUQT(const Params& p, int l) { return (unsigned short*)(p.ws + WS_WUQ + (size_t)l * SZ_WUQ); }
DEV unsigned short* WUKVT(const Params& p, int l) { return (unsigned short*)(p.ws + WS_WUKV + (size_t)l * SZ_WUKV); }
DEV unsigned short* WLRUT(const Params& p, int l, int gate) { return (unsigned short*)(p.ws + WS_WLRU + (size_t)(l * 2 + gate) * SZ_WLRU); }

DEV void transpose_item(const float* W, int ldw, int nvalid, const float* kscale, unsigned short* WT, int ldk, int dst_row0, int k0, int n0, float* scr, int lane) {
#pragma unroll 4
    for (int i = 0; i < 32; ++i) {
        const int kk = 2 * i + (lane >> 5), n = n0 + (lane & 31);
        float v = (n < nvalid) ? W[(size_t)(k0 + kk) * ldw + n] : 0.f;
        if (kscale) v *= kscale[k0 + kk];
        scr[kk * 33 + (lane & 31)] = v;
    }
    wsync();
    const int c = lane & 7;
#pragma unroll
    for (int j = 0; j < 4; ++j) {
        const int n = (lane >> 3) + 8 * j; const float* s = scr + (8 * c) * 33 + n;
        u32x4 o; o.x = pk2(s[0 * 33], s[1 * 33]); o.y = pk2(s[2 * 33], s[3 * 33]); o.z = pk2(s[4 * 33], s[5 * 33]); o.w = pk2(s[6 * 33], s[7 * 33]);
        *(u32x4*)(WT + (size_t)(dst_row0 + n) * ldk + k0 + 8 * c) = o;
    }
    wsync();
}
constexpr int IT_FFN = 1408, IT_LAYER = 6 * IT_FFN + 1408 + 512 + 48 + 32 + 16;
DEV void phase_prologue(const Params& p) {
    const int t = tid(), lane = t & 63, w = t >> 6;
    float* scr = (float*)(lds_base() + w * 16384);
    const int gw = bid() * 8 + w, NGW = nblk() * 8;
    for (int it = gw; it < DEPTH * IT_LAYER; it += NGW) {
        const int l = it / IT_LAYER; int r = it % IT_LAYER;
        if (r < 6 * IT_FFN) {
            const int fk = r / IT_FFN, f = fk / 3, kind = fk % 3, q = r % IT_FFN;
            if (kind < 2) {
                const int kb = q / 88, nbk = q % 88, n0 = 32 * nbk;
                transpose_item((kind ? p.in[4] : p.in[3]) + (size_t)(l * 2 + f) * D * DFF, DFF, DFF, nullptr, W13T(p, l, f), D, (n0 / 128) * 256 + kind * 128 + (n0 % 128), 64 * kb, n0, scr, lane);
            } else {
                const int kb = q / 32, nbk = q % 32, n0 = 32 * nbk;
                transpose_item(p.in[5] + (size_t)(l * 2 + f) * DFF * D, D, D, nullptr, W2T(p, l, f), DFF, n0, 64 * kb, n0, scr, lane);
            }
            continue;
        }
        r -= 6 * IT_FFN;
        if (r < 1408) { const int kb = r / 88, n0 = 32 * (r % 88); transpose_item(p.in[6] + (size_t)l * D * NIN, NIN, NIN, nullptr, WINT(p, l), D, n0, 64 * kb, n0, scr, lane); continue; }
        r -= 1408;
        if (r < 512) { const int kb = r / 32, n0 = 32 * (r % 32); transpose_item(p.in[21] + (size_t)l * D * D, D, D, nullptr, WOUTT(p, l), D, n0, 64 * kb, n0, scr, lane); continue; }
        r -= 512;
        if (r < 48) { const int kb = r / 12, n0 = 32 * (r % 12); transpose_item(p.in[9] + (size_t)l * 256 * 384, 384, 384, p.in[7] + l * 256, WUQT(p, l), 256, n0, 64 * kb, n0, scr, lane); continue; }
        r -= 48;
        if (r < 32) { const int kb = r / 16, n0 = 32 * (r % 16); transpose_item(p.in[10] + (size_t)l * 128 * 512, 512, 512, p.in[8] + l * 128, WUKVT(p, l), 128, n0, 64 * kb, n0, scr, lane); continue; }
        r -= 32;
        { const int gate = r / 8, h = (r % 8) / 2, n0 = 32 * (r % 2);
          transpose_item((gate ? p.in[15] : p.in[13]) + (size_t)(l * 4 + h) * 4096, 64, 64, nullptr, WLRUT(p, l, gate) + h * 4096, 64, n0, 0, n0, scr, lane); }
    }
    unsigned short* XB = (unsigned short*)(p.ws + WS_XB);
    for (int m = gw; m < M; m += NGW) {
        const float* xr = p.in[0] + (size_t)m * D;
#pragma unroll
        for (int j = 0; j < 4; ++j) { const f32x4 v = *(const f32x4*)(xr + 4 * lane + 256 * j); u32x2 o; o.x = pk2(v.x, v.y); o.y = pk2(v.z, v.w); *(u32x2*)(XB + (size_t)m * D + 4 * lane + 256 * j) = o; }
    }
    float* COS = (float*)(p.ws + WS_ROPE); float* SIN = COS + SEQ * 16;
    for (int idx = bid() * 512 + t; idx < SEQ * 16; idx += nblk() * 512) {
        const int pos = idx >> 4, i = idx & 15;
        const float fr = ex2(-(float)i * 0.83048202372184059f);
        const float a = (float)pos * fr;
        const double rev = (double)a * 0.15915494309189535; const float fx = (float)(rev - (double)(long long)rev);
        COS[idx] = cos_rev(fx); SIN[idx] = sin_rev(fx);
    }
}

DEV void phase_ln(const Params& p, int l, int j) {
    const float* g = p.in[1] + (size_t)(l * 3 + j) * D; const float* bb = p.in[2] + (size_t)(l * 3 + j) * D;
    unsigned short* XB = (unsigned short*)(p.ws + WS_XB);
    const int t = tid(), lane = t & 63, gw = bid() * 8 + (t >> 6), NGW = nblk() * 8;
    for (int m = gw; m < M; m += NGW) {
        float* xr = p.out + (size_t)m * D; f32x4 v[4]; float s = 0.f;
#pragma unroll
        for (int q = 0; q < 4; ++q) { v[q] = *(const f32x4*)(xr + 4 * lane + 256 * q); s += (v[q].x + v[q].y) + (v[q].z + v[q].w); }
        const float mean = wave_sum(s) * (1.f / D); float s2 = 0.f;
#pragma unroll
        for (int q = 0; q < 4; ++q) { v[q] = v[q] - mean; s2 += (v[q].x * v[q].x + v[q].y * v[q].y) + (v[q].z * v[q].z + v[q].w * v[q].w); }
        const float rstd = 1.0f / sqrtf(wave_sum(s2) * (1.f / D) + 1e-5f);
#pragma unroll
        for (int q = 0; q < 4; ++q) {
            const f32x4 gg = *(const f32x4*)(g + 4 * lane + 256 * q), b4 = *(const f32x4*)(bb + 4 * lane + 256 * q);
            const f32x4 o = v[q] * rstd * gg + b4;
            *(f32x4*)(xr + 4 * lane + 256 * q) = o;
            u32x2 ob; ob.x = pk2(o.x, o.y); ob.y = pk2(o.z, o.w); *(u32x2*)(XB + (size_t)m * D + 4 * lane + 256 * q) = ob;
        }
    }
}

DEV void mla_prep_unit(const Params& p, int l, int u) {
    const int t = tid(), lane = t & 63, w = t >> 6, r32 = lane & 31, hi = lane >> 5, tb = w & 1, sub = w >> 1;
    const size_t row = (size_t)u * 64 + 32 * tb + r32;
    const int pos = (int)(row % SEQ);
    const unsigned short* zr = (const unsigned short*)(p.ws + WS_HZ) + row * NINP;
    unsigned short* QM = (unsigned short*)(p.ws + WS_QM) + row * 384;
    unsigned short* KM = (unsigned short*)(p.ws + WS_KM) + row * 384;
    unsigned short* VM = (unsigned short*)(p.ws + WS_VM) + row * 256;
    const float* COS = (const float*)(p.ws + WS_ROPE) + pos * 16; const float* SIN = COS + SEQ * 16;
    bf16x8 cq[16]; float sq = 0.f;
#pragma unroll
    for (int ks = 0; ks < 16; ++ks) { cq[ks] = *(const bf16x8*)(zr + ZC_CQ + 16 * ks + 8 * hi);
#pragma unroll
        for (int j = 0; j < 8; ++j) { const float f = bfs2f(cq[ks][j]); sq += f * f; } }
    sq += shfl_xor(sq, 32); const float rq = 1.0f / sqrtf(sq * (1.f / 256.f) + 1e-6f);
    bf16x8 ck[8]; float sk = 0.f;
#pragma unroll
    for (int ks = 0; ks < 8; ++ks) { ck[ks] = *(const bf16x8*)(zr + ZC_CKV + 16 * ks + 8 * hi);
#pragma unroll
        for (int j = 0; j < 8; ++j) { const float f = bfs2f(ck[ks][j]); sk += f * f; } }
    sk += shfl_xor(sk, 32); const float rk = 1.0f / sqrtf(sk * (1.f / 128.f) + 1e-6f);
    const unsigned short* Wq = WUQT(p, l); const unsigned short* Wkv = WUKVT(p, l);
#pragma unroll 1
    for (int part = 0; part < 3; ++part) {
        f32x16 acc = {};
        const unsigned short* wr = Wq + (size_t)(96 * sub + 32 * part + r32) * 256 + 8 * hi;
#pragma unroll
        for (int ks = 0; ks < 16; ++ks) acc = mfma32(*(const bf16x8*)(wr + 16 * ks), cq[ks], acc);
        acc = acc * rq;
        if (part == 2) {
#pragma unroll
            for (int reg = 0; reg < 8; ++reg) { const int i = crow(reg, hi); const float c = COS[i], s = SIN[i], x1 = acc[reg], x2 = acc[reg + 8]; acc[reg] = x1 * c - x2 * s; acc[reg + 8] = x1 * s + x2 * c; }
        }
#pragma unroll
        for (int g = 0; g < 4; ++g) { u32x2 o; o.x = pk2(acc[4 * g], acc[4 * g + 1]); o.y = pk2(acc[4 * g + 2], acc[4 * g + 3]); *(u32x2*)(QM + 96 * sub + 32 * part + 8 * g + 4 * hi) = o; }
    }
#pragma unroll 1
    for (int kb = 0; kb < 4; ++kb) {
        f32x16 acc = {};
        const unsigned short* wr = Wkv + (size_t)(128 * sub + 32 * kb + r32) * 128 + 8 * hi;
#pragma unroll
        for (int ks = 0; ks < 8; ++ks) acc = mfma32(*(const bf16x8*)(wr + 16 * ks), ck[ks], acc);
        acc = acc * rk;
        unsigned short* dst = (kb < 2) ? (KM + 96 * sub + 32 * kb) : (VM + 64 * sub + 32 * (kb - 2));
#pragma unroll
        for (int g = 0; g < 4; ++g) { u32x2 o; o.x = pk2(acc[4 * g], acc[4 * g + 1]); o.y = pk2(acc[4 * g + 2], acc[4 * g + 3]); *(u32x2*)(dst + 8 * g + 4 * hi) = o; }
    }
    {
        const bf16x8 x1 = *(const bf16x8*)(zr + ZC_KR + 8 * hi), x2 = *(const bf16x8*)(zr + ZC_KR + 16 + 8 * hi);
        float o1[8], o2[8];
#pragma unroll
        for (int j = 0; j < 8; ++j) { const float c = COS[8 * hi + j], s = SIN[8 * hi + j], a = bfs2f(x1[j]), b = bfs2f(x2[j]); o1[j] = a * c - b * s; o2[j] = a * s + b * c; }
        *(bf16x8*)(KM + 96 * sub + 64 + 8 * hi) = pack8(o1[0], o1[1], o1[2], o1[3], o1[4], o1[5], o1[6], o1[7]);
        *(bf16x8*)(KM + 96 * sub + 80 + 8 * hi) = pack8(o2[0], o2[1], o2[2], o2[3], o2[4], o2[5], o2[6], o2[7]);
    }
}

constexpr int LRU_P = 264;
template <int MODE> DEV void lru_unit(const Params& p, int l, int u) {
    const int t = tid(), lane = t & 63, w = t >> 6, r32 = lane & 31, hi = lane >> 5;
    unsigned char* lds = lds_base();
    float* XCf = (float*)lds;
    float* Af = (float*)(lds + 32 * LRU_P * 4);
    unsigned short* XBb = (unsigned short*)(lds + 2 * 32 * LRU_P * 4);
    const unsigned short* Z = (const unsigned short*)(p.ws + WS_HZ);
    const int chk = u % NLC; const size_t rowbase = (size_t)u * 32; const int pos0 = chk * 32;
    {
        const int tt = t >> 4, c0 = (t & 15) * 16;
        float acc[16];
#pragma unroll
        for (int i = 0; i < 16; ++i) acc[i] = p.in[12][l * 256 + c0 + i];
#pragma unroll
        for (int j = 0; j < 4; ++j) {
            const int pp = pos0 + tt - 3 + j;
            if (pp >= 0) {
                const unsigned short* src = Z + (rowbase + tt - 3 + j) * NINP + ZC_LX + c0;
                const bf16x8 x0 = *(const bf16x8*)src, x1 = *(const bf16x8*)(src + 8);
                const float* wj = p.in[11] + (size_t)(l * 4 + j) * 256 + c0;
#pragma unroll
                for (int i = 0; i < 8; ++i) { acc[i] += wj[i] * bfs2f(x0[i]); acc[8 + i] += wj[8 + i] * bfs2f(x1[i]); }
            }
        }
#pragma unroll
        for (int i = 0; i < 16; ++i) { XCf[tt * LRU_P + c0 + i] = acc[i]; XBb[tt * LRU_P + c0 + i] = f2bf(acc[i]); }
    }
    bsync();
    {
        const int h = w >> 1, jh = w & 1;
        f32x16 aa = {}, ax = {};
        const unsigned short* Wa = WLRUT(p, l, 0) + h * 4096 + (32 * jh + r32) * 64 + 8 * hi;
        const unsigned short* Wx = WLRUT(p, l, 1) + h * 4096 + (32 * jh + r32) * 64 + 8 * hi;
#pragma unroll
        for (int ks = 0; ks < 4; ++ks) {
            const bf16x8 bfr = *(const bf16x8*)(XBb + r32 * LRU_P + 64 * h + 16 * ks + 8 * hi);
            aa = mfma32(*(const bf16x8*)(Wa + 16 * ks), bfr, aa);
            ax = mfma32(*(const bf16x8*)(Wx + 16 * ks), bfr, ax);
        }
#pragma unroll
        for (int reg = 0; reg < 16; ++reg) {
            const int ch = 64 * h + 32 * jh + crow(reg, hi);
            const float r = sigmoidf_(aa[reg] + p.in[14][l * 256 + ch]);
            const float ig = sigmoidf_(ax[reg] + p.in[16][l * 256 + ch]);
            const float lam = p.in[17][l * 256 + ch];
            const float sp = (lam > 0.f) ? log1pf(expf(-lam)) : (-lam + log1pf(expf(lam)));
            const float la = -8.0f * r * sp;
            const float a = expf(la);
            const float xc = XCf[r32 * LRU_P + ch];
            const float uu = sqrtf(-expm1f(2.0f * la)) * ig * xc;
            Af[r32 * LRU_P + ch] = a; XCf[r32 * LRU_P + ch] = uu;
        }
    }
    bsync();
    if (t < 256) {
        const int ch = t;
        float hh = MODE ? ((const float*)(p.ws + WS_LCR))[(size_t)u * 256 + ch] : 0.f, P = 1.f;
#pragma unroll 8
        for (int tt = 0; tt < 32; ++tt) { const float a = Af[tt * LRU_P + ch], uu = XCf[tt * LRU_P + ch]; hh = a * hh + uu; P *= a; if (MODE) XCf[tt * LRU_P + ch] = hh; }
        if (!MODE) { ((float*)(p.ws + WS_LAC))[(size_t)u * 256 + ch] = P; ((float*)(p.ws + WS_LHC))[(size_t)u * 256 + ch] = hh; }
    }
    bsync();
    if (MODE) {
        const int tt = t >> 4, c0 = (t & 15) * 16; const size_t row = rowbase + tt;
        const unsigned short* gsrc = Z + row * NINP + ZC_LG + c0;
        const bf16x8 g0 = *(const bf16x8*)gsrc, g1 = *(const bf16x8*)(gsrc + 8);
        float y[16], ss = 0.f;
#pragma unroll
        for (int i = 0; i < 16; ++i) {
            const float gx = bfs2f(i < 8 ? g0[i & 7] : g1[i & 7]);
            const float ge = 0.5f * gx * (1.0f + tanhf(0.7978845608028654f * (gx + 0.044715f * gx * gx * gx)));
            y[i] = XCf[tt * LRU_P + c0 + i] * ge; ss += y[i] * y[i];
        }
        ss += shfl_xor(ss, 1); ss += shfl_xor(ss, 2); ss += shfl_xor(ss, 4); ss += shfl_xor(ss, 8);
        const float rstd = 1.0f / sqrtf(ss * (1.f / 256.f) + 1e-6f);
        const float* on = p.in[20] + (size_t)l * D + 256 + c0;
        unsigned short* dst = (unsigned short*)(p.ws + WS_XB) + row * D + 256 + c0;
        *(bf16x8*)dst = pack8(y[0] * rstd * on[0], y[1] * rstd * on[1], y[2] * rstd * on[2], y[3] * rstd * on[3], y[4] * rstd * on[4], y[5] * rstd * on[5], y[6] * rstd * on[6], y[7] * rstd * on[7]);
        *(bf16x8*)(dst + 8) = pack8(y[8] * rstd * on[8], y[9] * rstd * on[9], y[10] * rstd * on[10], y[11] * rstd * on[11], y[12] * rstd * on[12], y[13] * rstd * on[13], y[14] * rstd * on[14], y[15] * rstd * on[15]);
        bsync();
    }
}

DEV void mlstm_gates(const Params& p, int l, int h, size_t row, float& b, float& a) {
    const float* gf = (const float*)(p.ws + WS_GF) + row * 8;
    const float gi = gf[h] + p.in[18][l * 4 + h];
    const float fx = gf[4 + h] + p.in[19][l * 4 + h];
    const float lf = fminf(fx, 0.f) - log1pf(expf(-fabsf(fx)));
    float s = lf;
#pragma unroll
    for (int d = 1; d < 64; d <<= 1) { const float o = shfl_up(s, d); if ((tid() & 63) >= d) s += o; }
    b = s; a = gi - s;
}
constexpr int MP = 72;
DEV void mlstm_local_unit(const Params& p, int l, int u) {
    const int t = tid(), lane = t & 63, w = t >> 6, r32 = lane & 31, hi = lane >> 5, h = w >> 1, half = w & 1;
    unsigned char* lds = lds_base();
    unsigned short* Kt = (unsigned short*)(lds + h * (2 * 64 * MP * 2));
    unsigned short* Vt = Kt + 64 * MP;
    const unsigned short* Z = (const unsigned short*)(p.ws + WS_HZ);
    const size_t row = (size_t)u * 64 + lane;
    float b, a; mlstm_gates(p, l, h, row, b, a);
    const float A = wave_max(a), g = shfl_idx(b, 63);
    const float wgt = expf(a - A) * 0.125f;
    {
        const unsigned short* src = Z + row * NINP + (half ? ZC_MV : ZC_MK) + 64 * h;
        unsigned short* dstT = half ? Vt : Kt; const float sc = half ? 1.0f : wgt;
#pragma unroll
        for (int c = 0; c < 8; ++c) { const bf16x8 x = *(const bf16x8*)(src + 8 * c);
#pragma unroll
            for (int j = 0; j < 8; ++j) dstT[(8 * c + j) * MP + lane] = half ? (unsigned short)x[j] : f2bf(bfs2f(x[j]) * sc); }
    }
    bsync();
    const int b_ = u / NC, c_ = u % NC; const size_t bhc = ((size_t)(b_ * 4 + h) * NC + c_);
    {
        f32x16 acc[2] = {{}, {}};
#pragma unroll
        for (int ks = 0; ks < 4; ++ks) {
            const bf16x8 af = *(const bf16x8*)(Kt + (32 * half + r32) * MP + 16 * ks + 8 * hi);
#pragma unroll
            for (int fb = 0; fb < 2; ++fb) acc[fb] = mfma32(af, *(const bf16x8*)(Vt + (32 * fb + r32) * MP + 16 * ks + 8 * hi), acc[fb]);
        }
        float* CT = (float*)(p.ws + WS_CT) + bhc * 4096;
#pragma unroll
        for (int fb = 0; fb < 2; ++fb)
#pragma unroll
            for (int gq = 0; gq < 4; ++gq) { f32x4 o = {acc[fb][4 * gq], acc[fb][4 * gq + 1], acc[fb][4 * gq + 2], acc[fb][4 * gq + 3]}; *(f32x4*)(CT + (32 * fb + r32) * 64 + 32 * half + 8 * gq + 4 * hi) = o; }
    }
    if (half == 0) { float s = 0.f;
#pragma unroll 8
        for (int q = 0; q < 64; ++q) s += bf2f(Kt[lane * MP + q]);
        ((float*)(p.ws + WS_NU))[bhc * 64 + lane] = s; }
    else if (lane == 0) { float* ag = (float*)(p.ws + WS_AG) + bhc * 2; ag[0] = A; ag[1] = g; }
    bsync();
}

DEV void phase_m1(const Params& p, int l) {
    if (UM(0)) for (int u = bid(); u < M / 64; u += nblk()) mla_prep_unit(p, l, u);
    if (UM(1)) for (int u = bid(); u < M / 64; u += nblk()) mlstm_local_unit(p, l, u);
    if (UM(2)) for (int u = bid(); u < M / 32; u += nblk()) lru_unit<0>(p, l, u);
}

DEV void phase_m1b(const Params& p) {
    const int gt = bid() * 512 + tid(), NT_ = nblk() * 512;
    const float* AG = (const float*)(p.ws + WS_AG);
    for (int idx = gt; idx < NB * 4 * (4096 + 64); idx += NT_) {
        const bool isn = idx >= NB * 4 * 4096;
        const int q = isn ? idx - NB * 4 * 4096 : idx, per = isn ? 64 : 4096;
        const int bh = q / per, el = q % per;
        float* base = (isn ? (float*)(p.ws + WS_NU) : (float*)(p.ws + WS_CT)) + (size_t)bh * NC * per + el;
        float uv[NC];
#pragma unroll
        for (int c = 0; c < NC; ++c) uv[c] = base[(size_t)c * per];
        float m = 0.f, C = 0.f;
#pragma unroll
        for (int c = 0; c < NC; ++c) {
            const float A = AG[(bh * NC + c) * 2], g = AG[(bh * NC + c) * 2 + 1];
            const float Mx = fmaxf(m, A);
            base[(size_t)c * per] = C;
            if (isn && el == 0) ((float*)(p.ws + WS_MS))[bh * NC + c] = m;
            C = expf(m - Mx) * C + expf(A - Mx) * uv[c];
            m = g + Mx;
        }
    }
    const float* LAC = (const float*)(p.ws + WS_LAC); const float* LHC = (const float*)(p.ws + WS_LHC); float* LCR = (float*)(p.ws + WS_LCR);
    for (int idx = gt; idx < NB * 256; idx += NT_) {
        const int b = idx / 256, ch = idx % 256; float carry = 0.f;
        for (int c = 0; c < NLC; ++c) { const size_t o = ((size_t)(b * NLC + c)) * 256 + ch; LCR[o] = carry; carry = LAC[o] * carry + LHC[o]; }
    }
}

constexpr float NEGBIG = -1e30f;
DEV float dil_madd(int rel) {
    const int mult = (rel <= 128 ? 1 : 0) + ((((rel & 3) == 0) && rel <= 512) ? 1 : 0) + ((((rel & 15) == 0) && rel <= 2048) ? 1 : 0);
    const float v = (mult == 1) ? 0.f : ((mult == 2) ? 1.0f : 1.5849625007211562f);
    return (rel < 0 || mult == 0) ? NEGBIG : v;
}
DEV void group_norm_store(const Params& p, int l, f32x16 (&o)[2], float* red, int gcol, int h, int rh, int r32, int hi, size_t grow) {
    float ss = 0.f;
#pragma unroll
    for (int blk = 0; blk < 2; ++blk)
#pragma unroll
        for (int reg = 0; reg < 16; ++reg) ss += o[blk][reg] * o[blk][reg];
    ss += shfl_xor(ss, 32);
    if (hi == 0) red[(32 * rh + r32) * 4 + h] = ss;
    bsync();
    const float tot = (red[(32 * rh + r32) * 4 + 0] + red[(32 * rh + r32) * 4 + 1]) + (red[(32 * rh + r32) * 4 + 2] + red[(32 * rh + r32) * 4 + 3]);
    const float rstd = 1.0f / sqrtf(tot * (1.f / 256.f) + 1e-6f);
    const float* on = p.in[20] + (size_t)l * D + gcol + 64 * h;
    unsigned short* dst = (unsigned short*)(p.ws + WS_XB) + grow * D + gcol + 64 * h;
#pragma unroll
    for (int blk = 0; blk < 2; ++blk)
#pragma unroll
        for (int g = 0; g < 4; ++g) { const int d0 = 32 * blk + 8 * g + 4 * hi; const f32x4 w4 = *(const f32x4*)(on + d0);
            u32x2 ov; ov.x = pk2(o[blk][4 * g] * rstd * w4.x, o[blk][4 * g + 1] * rstd * w4.y); ov.y = pk2(o[blk][4 * g + 2] * rstd * w4.z, o[blk][4 * g + 3] * rstd * w4.w);
            *(u32x2*)(dst + d0) = ov; }
    bsync();
}

template <int EQK, bool DIL> DEV void attn_unit(const Params& p, int l, int b, int qb) {
    const int t = tid(), lane = t & 63, w = t >> 6, h = w >> 1, rh = w & 1, r32 = lane & 31, hi = lane >> 5;
    constexpr int KP = EQK + 8, KBYTES = 64 * KP * 2, VBYTES = 64 * MP * 2, HB = KBYTES + VBYTES;
    constexpr int CPT = EQK / 2;
    constexpr int NKC = EQK / 16;
    unsigned char* lds = lds_base();
    const unsigned short* Ks = (const unsigned short*)(lds + h * HB);
    const unsigned short* Vt = (const unsigned short*)(lds + h * HB + KBYTES);
    float* red = (float*)(lds + 4 * HB);
    const unsigned short* Z = (const unsigned short*)(p.ws + WS_HZ);
    const unsigned short *Qg, *Kg, *Vg; int pq, pk, pv; float sc;
    if (DIL) { Qg = Z + ZC_SQ; Kg = Z + ZC_SK; Vg = Z + ZC_SV; pq = pk = pv = NINP; sc = 0.125f * LOG2E; }
    else { Qg = (const unsigned short*)(p.ws + WS_QM); Kg = (const unsigned short*)(p.ws + WS_KM); Vg = (const unsigned short*)(p.ws + WS_VM); pq = pk = 384; pv = 256; sc = 0.10206207261596577f * LOG2E; }
    const size_t row0 = (size_t)b * SEQ; const int q0 = qb * 64, qpos = q0 + 32 * rh + r32;
    bf16x8 qf[EQK / 16];
#pragma unroll
    for (int ks = 0; ks < EQK / 16; ++ks) qf[ks] = *(const bf16x8*)(Qg + (row0 + qpos) * pq + h * EQK + 16 * ks + 8 * hi);
    const int nt = qb + 1;
    bf16x8 kreg[NKC], vreg[4];
    auto prefetch = [&](int kv0) {
#pragma unroll
        for (int i = 0; i < NKC; ++i) { const int id = t + 512 * i, tok = id / CPT, c = id % CPT; kreg[i] = *(const bf16x8*)(Kg + (row0 + kv0 + tok) * pk + c * 8); }
#pragma unroll
        for (int i = 0; i < 4; ++i) { const int c = w + 8 * i; vreg[i] = *(const bf16x8*)(Vg + (row0 + kv0 + lane) * pv + c * 8); }
    };
    auto stage = [&]() {
#pragma unroll
        for (int i = 0; i < NKC; ++i) { const int id = t + 512 * i, tok = id / CPT, c = id % CPT, hd = c / (EQK / 8), wi = c % (EQK / 8);
            *(bf16x8*)(lds + hd * HB + (tok * KP + wi * 8) * 2) = kreg[i]; }
#pragma unroll
        for (int i = 0; i < 4; ++i) { const int c = w + 8 * i, hd = c >> 3, dc = c & 7; unsigned short* vt = (unsigned short*)(lds + hd * HB + KBYTES);
#pragma unroll
            for (int j = 0; j < 8; ++j) vt[(8 * dc + j) * MP + lane] = (unsigned short)vreg[i][j]; }
    };
    f32x16 o[2] = {{}, {}};
    float m_run = NEGBIG, l_run = 0.f;
    prefetch(0);
    for (int tt = 0; tt < nt; ++tt) {
        const int kv0 = tt * 64;
        bsync();
        stage();
        if (tt + 1 < nt) prefetch(kv0 + 64);
        bsync();
        f32x16 p0 = {}, p1 = {};
#pragma unroll
        for (int ks = 0; ks < EQK / 16; ++ks) {
            p0 = mfma32(*(const bf16x8*)(Ks + r32 * KP + 16 * ks + 8 * hi), qf[ks], p0);
            p1 = mfma32(*(const bf16x8*)(Ks + (32 + r32) * KP + 16 * ks + 8 * hi), qf[ks], p1);
        }
        float mx = NEGBIG;
        if (DIL) {
#pragma unroll
            for (int reg = 0; reg < 16; ++reg) { const int rel = qpos - (kv0 + crow(reg, hi));
                p0[reg] = p0[reg] * sc + dil_madd(rel); p1[reg] = p1[reg] * sc + dil_madd(rel - 32); mx = fmaxf(mx, fmaxf(p0[reg], p1[reg])); }
        } else {
            const bool diag = (tt == nt - 1);
#pragma unroll
            for (int reg = 0; reg < 16; ++reg) { const int rel = qpos - (kv0 + crow(reg, hi));
                p0[reg] = (diag && rel < 0) ? NEGBIG : p0[reg] * sc; p1[reg] = (diag && rel - 32 < 0) ? NEGBIG : p1[reg] * sc; mx = fmaxf(mx, fmaxf(p0[reg], p1[reg])); }
        }
        mx = fmaxf(mx, shfl_xor(mx, 32));
        const float m_new = fmaxf(m_run, mx), alpha = ex2(m_run - m_new); m_run = m_new;
        float ls = 0.f;
#pragma unroll
        for (int reg = 0; reg < 16; ++reg) { p0[reg] = ex2(p0[reg] - m_new); p1[reg] = ex2(p1[reg] - m_new); ls += p0[reg] + p1[reg]; }
        l_run = l_run * alpha + ls;
        o[0] = o[0] * alpha; o[1] = o[1] * alpha;
        bf16x8 pf[4];
        pf[0] = pack8(p0[0], p0[1], p0[2], p0[3], p0[4], p0[5], p0[6], p0[7]); pf[1] = pack8(p0[8], p0[9], p0[10], p0[11], p0[12], p0[13], p0[14], p0[15]);
        pf[2] = pack8(p1[0], p1[1], p1[2], p1[3], p1[4], p1[5], p1[6], p1[7]); pf[3] = pack8(p1[8], p1[9], p1[10], p1[11], p1[12], p1[13], p1[14], p1[15]);
#pragma unroll
        for (int s = 0; s < 4; ++s)
#pragma unroll
            for (int blk = 0; blk < 2; ++blk) {
                const unsigned short* vp = Vt + (32 * blk + r32) * MP + 16 * s + 4 * hi;
                const bf16x4 lo = *(const bf16x4*)vp, hh = *(const bf16x4*)(vp + 8);
                const bf16x8 af = {lo[0], lo[1], lo[2], lo[3], hh[0], hh[1], hh[2], hh[3]};
                o[blk] = mfma32(af, pf[s], o[blk]);
            }
    }
    l_run += shfl_xor(l_run, 32);
    const float inv = 1.0f / l_run;
    o[0] = o[0] * inv; o[1] = o[1] * inv;
    bsync();
    group_norm_store(p, l, o, red, DIL ? 512 : 0, h, rh, r32, hi, row0 + qpos);
}

DEV void mlstm_out_unit(const Params& p, int l, int u) {
    const int t = tid(), lane = t & 63, w = t >> 6, r32 = lane & 31, hi = lane >> 5, h = w >> 1, half = w & 1;
    constexpr int HB = 3 * 64 * MP * 2 + 512;
    unsigned char* lds = lds_base();
    unsigned short* Ks = (unsigned short*)(lds + h * HB);
    unsigned short* Vt = Ks + 64 * MP;
    unsigned short* Cb = Vt + 64 * MP;
    float* nv = (float*)(lds + h * HB + 3 * 64 * MP * 2);
    float* av = nv + 64;
    float* red = (float*)(lds + 4 * HB);
    const unsigned short* Z = (const unsigned short*)(p.ws + WS_HZ);
    const int b_ = u / NC, c_ = u % NC; const size_t bhc = ((size_t)(b_ * 4 + h) * NC + c_);
    const size_t row = (size_t)u * 64 + lane;
    float b, a; mlstm_gates(p, l, h, row, b, a);
    float cm = a;
#pragma unroll
    for (int d = 1; d < 64; d <<= 1) { const float ov = shfl_up(cm, d); if (lane >= d) cm = fmaxf(cm, ov); }
    const float mprev = ((const float*)(p.ws + WS_MS))[bhc];
    const float Mt_l = fmaxf(cm, mprev);
    const int tq = 32 * half + r32;
    const float Mt = shfl_idx(Mt_l, tq), bt = shfl_idx(b, tq);
    const float winter = expf(mprev - Mt), emt = expf(-(bt + Mt));
    av[lane] = a;
    {
        const unsigned short* src = Z + row * NINP + (half ? ZC_MV : ZC_MK) + 64 * h;
#pragma unroll
        for (int c = 0; c < 8; ++c) { const bf16x8 x = *(const bf16x8*)(src + 8 * c);
            if (half) {
#pragma unroll
                for (int j = 0; j < 8; ++j) Vt[(8 * c + j) * MP + lane] = (unsigned short)x[j];
            } else *(bf16x8*)(Ks + lane * MP + 8 * c) = x; }
        const int q = half * 64 + lane, f = q >> 1, e0 = (q & 1) * 32;
        const float* csrc = (const float*)(p.ws + WS_CT) + bhc * 4096 + f * 64 + e0;
#pragma unroll
        for (int i = 0; i < 4; ++i) { const f32x4 x0 = *(const f32x4*)(csrc + 8 * i), x1 = *(const f32x4*)(csrc + 8 * i + 4);
            *(bf16x8*)(Cb + f * MP + e0 + 8 * i) = pack8(x0.x, x0.y, x0.z, x0.w, x1.x, x1.y, x1.z, x1.w); }
        if (half == 0) nv[lane] = ((const float*)(p.ws + WS_NU))[bhc * 64 + lane];
    }
    bsync();
    const size_t grow = (size_t)u * 64 + tq;
    bf16x8 qf[4];
#pragma unroll
    for (int ks = 0; ks < 4; ++ks) qf[ks] = *(const bf16x8*)(Z + grow * NINP + ZC_MQ + 64 * h + 16 * ks + 8 * hi);
    f32x16 p0 = {}, p1 = {};
#pragma unroll
    for (int ks = 0; ks < 4; ++ks) {
        p0 = mfma32(*(const bf16x8*)(Ks + r32 * MP + 16 * ks + 8 * hi), qf[ks], p0);
        p1 = mfma32(*(const bf16x8*)(Ks + (32 + r32) * MP + 16 * ks + 8 * hi), qf[ks], p1);
    }
    float dsum = 0.f;
#pragma unroll
    for (int reg = 0; reg < 16; ++reg) {
        const int s0 = crow(reg, hi), s1 = 32 + s0;
        const float c0 = (s0 <= tq) ? expf(av[s0] - Mt) * 0.125f : 0.f, c1 = (s1 <= tq) ? expf(av[s1] - Mt) * 0.125f : 0.f;
        p0[reg] *= c0; p1[reg] *= c1; dsum += p0[reg] + p1[reg];
    }
    dsum += shfl_xor(dsum, 32);
    bf16x8 pf[4];
    pf[0] = pack8(p0[0], p0[1], p0[2], p0[3], p0[4], p0[5], p0[6], p0[7]); pf[1] = pack8(p0[8], p0[9], p0[10], p0[11], p0[12], p0[13], p0[14], p0[15]);
    pf[2] = pack8(p1[0], p1[1], p1[2], p1[3], p1[4], p1[5], p1[6], p1[7]); pf[3] = pack8(p1[8], p1[9], p1[10], p1[11], p1[12], p1[13], p1[14], p1[15]);
    f32x16 o[2] = {{}, {}};
    float qn = 0.f;
#pragma unroll
    for (int ks = 0; ks < 4; ++ks) {
#pragma unroll
        for (int fb = 0; fb < 2; ++fb) o[fb] = mfma32(*(const bf16x8*)(Cb + (32 * fb + r32) * MP + 16 * ks + 8 * hi), qf[ks], o[fb]);
#pragma unroll
        for (int j = 0; j < 8; ++j) qn += bfs2f(qf[ks][j]) * nv[16 * ks + 8 * hi + j];
    }
    qn += shfl_xor(qn, 32);
    o[0] = o[0] * winter; o[1] = o[1] * winter;
#pragma unroll
    for (int s = 0; s < 4; ++s)
#pragma unroll
        for (int fb = 0; fb < 2; ++fb) {
            const unsigned short* vp = Vt + (32 * fb + r32) * MP + 16 * s + 4 * hi;
            const bf16x4 lo = *(const bf16x4*)vp, hh = *(const bf16x4*)(vp + 8);
            const bf16x8 af = {lo[0], lo[1], lo[2], lo[3], hh[0], hh[1], hh[2], hh[3]};
            o[fb] = mfma32(af, pf[s], o[fb]);
        }
    const float den = dsum + winter * qn;
    const float inv = 1.0f / fmaxf(fabsf(den), emt);
    const unsigned short* og = Z + grow * NINP + ZC_MO + 64 * h;
#pragma unroll
    for (int fb = 0; fb < 2; ++fb)
#pragma unroll
        for (int g = 0; g < 4; ++g) { const bf16x4 gv = *(const bf16x4*)(og + 32 * fb + 8 * g + 4 * hi);
#pragma unroll
            for (int i = 0; i < 4; ++i) o[fb][4 * g + i] = o[fb][4 * g + i] * inv * sigmoidf_(bfs2f(gv[i])); }
    group_norm_store(p, l, o, red, 768, h, half, r32, hi, grow);
}

DEV void phase_m2(const Params& p, int l) {
    if (UM(3)) for (int u = bid(); u < NB * NQ; u += nblk()) attn_unit<96, false>(p, l, u / NQ, u % NQ);
    if (UM(4)) for (int u = bid(); u < NB * NQ; u += nblk()) attn_unit<64, true>(p, l, u / NQ, NQ - 1 - (u % NQ));
    if (UM(5)) for (int u = bid(); u < M / 64; u += nblk()) mlstm_out_unit(p, l, u);
    if (UM(6)) for (int u = bid(); u < M / 32; u += nblk()) lru_unit<1>(p, l, u);
}

#ifdef EMU
DEV float emu_dot(const unsigned short* a, const unsigned short* b, int K) { double s = 0; for (int k = 0; k < K; ++k) s += (double)bf2f(a[k]) * bf2f(b[k]); return (float)s; }
DEV void emu_gemm_up(const Params& p, int l, int f) {
    if (bid() != 0 || tid() != 0) return;
    const unsigned short* A = (const unsigned short*)(p.ws + WS_XB); const unsigned short* Bt = W13T(p, l, f); unsigned short* H = (unsigned short*)(p.ws + WS_HZ);
    for (int r = 0; r < M; ++r) for (int j = 0; j < DFF; ++j) { const int pn = j / 128, jj = j % 128;
        const float a = emu_dot(A + (size_t)r * D, Bt + (size_t)(256 * pn + jj) * D, D), g = emu_dot(A + (size_t)r * D, Bt + (size_t)(256 * pn + 128 + jj) * D, D);
        H[(size_t)r * DFF + j] = f2bf(a / (1.0f + expf(-a)) * g); }
}
DEV void emu_gemm_resid(const Params& p, const unsigned short* A, const unsigned short* Bt, int K, const float* base, float alpha, float coef) {
    if (bid() != 0 || tid() != 0) return;
    for (int r = 0; r < M; ++r) for (int c = 0; c < D; ++c) p.out[(size_t)r * D + c] = alpha * base[(size_t)r * D + c] + coef * emu_dot(A + (size_t)r * K, Bt + (size_t)c * K, K);
}
DEV void emu_gemm_z(const Params& p, int l) {
    if (bid() != 0 || tid() != 0) return;
    const unsigned short* A = (const unsigned short*)(p.ws + WS_XB); const unsigned short* Bt = WINT(p, l); unsigned short* Zb = (unsigned short*)(p.ws + WS_HZ); float* GF = (float*)(p.ws + WS_GF);
    for (int r = 0; r < M; ++r) for (int c = 0; c < NINP; ++c) { const float v = emu_dot(A + (size_t)r * D, Bt + (size_t)c * D, D); Zb[(size_t)r * NINP + c] = f2bf(v); if (c >= ZC_MI && c < ZC_MI + 8) GF[(size_t)r * 8 + c - ZC_MI] = v; }
}
#else
namespace pg8 {
#define PG8_LAS __attribute__((address_space(3)))
typedef unsigned short bf16_t;
constexpr int BM = 256, BK = 64, HALF = 128, HTB = HALF * BK * 2, STAGE_BYTES = 8 * HTB, NXCD = 8, WGM = 8;
__host__ __device__ __forceinline__ int lds_byte(int r, int c) { const int st = (r >> 4) * 2 + (c >> 5), rr = r & 15, cc = c & 31, ob = rr * 64 + cc * 2; return st * 1024 + (ob ^ (((ob >> 9) & 1) << 5)); }
__host__ __device__ __forceinline__ void stage_rc(int b, int& R, int& C) { const int st = b / 1024, sb = b % 1024, swz = sb ^ (((sb >> 9) & 1) << 5); R = (st >> 1) * 16 + swz / 64; C = (st & 1) * 32 + (swz % 64) / 2; }
__host__ __device__ __forceinline__ int perm32(int rho) { const int n = rho >> 4, i = rho & 15; return 8 * (i >> 2) + 4 * n + (i & 3); }
struct Unit { int pm, pn; };
struct Gemm { const bf16_t* A; const bf16_t* Bt; int M, N, K; };
struct StaticOrder {
    int nM, nN, nwg, G, c;
    __host__ __device__ void init(int M_, int N_, int G_, int c_) { nM = M_ / BM; nN = N_ / BM; nwg = nM * nN; G = G_; c = c_; }
    __host__ __device__ bool next(int i, Unit& u) const {
        const long L = (long)i * G + c; if (L >= nwg) return false;
        int wgid = (int)L; { const int q = nwg / NXCD, r = nwg % NXCD, xcd = wgid % NXCD, off = wgid / NXCD; wgid = (xcd < r ? xcd * (q + 1) : r * (q + 1) + (xcd - r) * q) + off; }
        const int nig = WGM * nN, gid = wgid / nig, fm = gid * WGM, gsz = (nM - fm) < WGM ? (nM - fm) : WGM;
        u.pm = fm + ((wgid % nig) % gsz); u.pn = (wgid % nig) / gsz; return true;
    }
    __device__ __forceinline__ void a_ready(const Unit&) const {}
    __device__ __forceinline__ void done(const Unit&) const {}
};
struct EpiSwiGLU {
    static constexpr bool PERM = true, AFTER_DRAIN = false;
    bf16_t* H;
    __device__ __forceinline__ void operator()(const f32x4 (&acc)[2][2][4][2], const Unit& u, int wr, int wc, int fr, int fq) const {
        const int row0 = u.pm * BM + wr * 64 + fr, col0 = u.pn * HALF + wc * 32 + 8 * fq;
#pragma unroll
        for (int ai = 0; ai < 2; ++ai)
#pragma unroll
            for (int m = 0; m < 4; ++m) {
                float hv[8];
#pragma unroll
                for (int n = 0; n < 2; ++n)
#pragma unroll
                    for (int i = 0; i < 4; ++i) { const float a = acc[ai][0][m][n][i], g = acc[ai][1][m][n][i]; hv[4 * n + i] = a * sigmoidf_(a) * g; }
                *(bf16x8*)(H + (size_t)(row0 + ai * HALF + m * 16) * DFF + col0) = pack8(hv[0], hv[1], hv[2], hv[3], hv[4], hv[5], hv[6], hv[7]);
            }
    }
};
struct EpiResid {
    static constexpr bool PERM = false, AFTER_DRAIN = false;
    const float* base; float* out; float alpha, coef;
    __device__ __forceinline__ void operator()(const f32x4 (&acc)[2][2][4][2], const Unit& u, int wr, int wc, int fr, int fq) const {
        const int row0 = u.pm * BM + wr * 64 + fr, col0 = u.pn * BM + wc * 32 + 4 * fq;
#pragma unroll
        for (int ai = 0; ai < 2; ++ai)
#pragma unroll
            for (int m = 0; m < 4; ++m) { const size_t off = (size_t)(row0 + ai * HALF + m * 16) * D + col0;
#pragma unroll
                for (int bj = 0; bj < 2; ++bj)
#pragma unroll
                    for (int n = 0; n < 2; ++n) { const f32x4 bs = *(const f32x4*)(base + off + bj * HALF + n * 16); *(f32x4*)(out + off + bj * HALF + n * 16) = bs * alpha + acc[ai][bj][m][n] * coef; } }
    }
};
struct EpiZ {
    static constexpr bool PERM = true, AFTER_DRAIN = false;
    bf16_t* Zb; float* GF;
    __device__ __forceinline__ void operator()(const f32x4 (&acc)[2][2][4][2], const Unit& u, int wr, int wc, int fr, int fq) const {
        const int row0 = u.pm * BM + wr * 64 + fr, col0 = u.pn * BM + wc * 32 + 8 * fq;
#pragma unroll
        for (int ai = 0; ai < 2; ++ai)
#pragma unroll
            for (int m = 0; m < 4; ++m) { const size_t r = (size_t)(row0 + ai * HALF + m * 16);
#pragma unroll
                for (int bj = 0; bj < 2; ++bj) { const f32x4 v0 = acc[ai][bj][m][0], v1 = acc[ai][bj][m][1];
                    *(bf16x8*)(Zb + r * NINP + col0 + bj * HALF) = pack8(v0[0], v0[1], v0[2], v0[3], v1[0], v1[1], v1[2], v1[3]);
                    if (col0 + bj * HALF == ZC_MI) { *(f32x4*)(GF + r * 8) = v0; *(f32x4*)(GF + r * 8 + 4) = v1; } } }
    }
};

template <class Epi, class Sched, bool ALIGN_EPI = false, bool SP2 = false>
__device__ __forceinline__ void gemm_phase(PG8_LAS unsigned char* lds, const Gemm g, const Sched& S, const Epi& E) {
    const int tid = ::tid(), wid = __builtin_amdgcn_readfirstlane(tid >> 6), lane = tid & 63, wr = wid >> 2, wc = wid & 3, fr = lane & 15, fq = lane >> 4;
    const int K = g.K, nt = K / BK;
    unsigned voffA[2], voffB[2];
#pragma unroll
    for (int i = 0; i < 2; ++i) { int R, C; stage_rc(tid * 16 + i * 8192, R, C); const int Rb = Epi::PERM ? ((R & ~31) + perm32(R & 31)) : R;
        voffA[i] = (unsigned)(R * K + C) * 2u; voffB[i] = (unsigned)(Rb * K + C) * 2u; }
    const size_t kstep = (size_t)(BK * 2);
    const size_t hstep = (size_t)HALF * K * 2;
    const size_t tstep = 2 * hstep;
    const unsigned ldsw = (unsigned)wid * 1024u;
    const int aoff = lds_byte(wr * 64 + fr, fq * 8), boff = lds_byte(wc * 32 + fr, fq * 8);
#define PG8_SA(b, h) (((b) * 2 + (h)) * HTB)
#define PG8_SB(b, h) ((4 + (b) * 2 + (h)) * HTB)
#define PG8_STAGE(bufoff, gbase, voff) do { _Pragma("unroll") for (int _i = 0; _i < 2; ++_i) \
        __builtin_amdgcn_global_load_lds((const unsigned*)((const char*)(gbase) + (voff)[_i]), (PG8_LAS unsigned*)(lds + (bufoff) + ldsw + _i * 8192), 16, 0, 0); } while (0)
#define PG8_LDA(dst, b, h) do { _Pragma("unroll") for (int m = 0; m < 4; ++m) _Pragma("unroll") for (int k = 0; k < 2; ++k) dst[m][k] = *(const PG8_LAS bf16x8*)(lds + PG8_SA(b, h) + aoff + m * 2048 + k * 1024); } while (0)
#define PG8_LDB(dst, b, h) do { _Pragma("unroll") for (int n = 0; n < 2; ++n) _Pragma("unroll") for (int k = 0; k < 2; ++k) dst[n][k] = *(const PG8_LAS bf16x8*)(lds + PG8_SB(b, h) + boff + n * 2048 + k * 1024); } while (0)
#define PG8_MMA(ai, bj, At, Bt) do { __builtin_amdgcn_s_setprio(1); _Pragma("unroll") for (int m = 0; m < 4; ++m) _Pragma("unroll") for (int n = 0; n < 2; ++n) _Pragma("unroll") for (int k = 0; k < 2; ++k) \
        acc[ai][bj][m][n] = __builtin_amdgcn_mfma_f32_16x16x32_bf16(Bt[n][k], At[m][k], acc[ai][bj][m][n], 0, 0, 0); __builtin_amdgcn_s_setprio(0); } while (0)
#define PG8_WAIT_V(n) asm volatile("s_waitcnt vmcnt(" #n ")" ::: "memory")
#define PG8_WAIT_L(n) asm volatile("s_waitcnt lgkmcnt(" #n ")" ::: "memory")
#define PG8_BAR __builtin_amdgcn_s_barrier()
#define PG8_SCHED __builtin_amdgcn_sched_barrier(0)
    Unit cur, nxt; int ui = 0;
    if (!S.next(0, cur)) return;
    f32x4 acc[2][2][4][2];
#pragma unroll
    for (int a = 0; a < 2; ++a)
#pragma unroll
        for (int b = 0; b < 2; ++b)
#pragma unroll
            for (int m = 0; m < 4; ++m)
#pragma unroll
                for (int n = 0; n < 2; ++n) acc[a][b][m][n] = (f32x4){0.f, 0.f, 0.f, 0.f};
    bf16x8 At[4][2], B0[2][2], B1[2][2];
    const char* cA = (const char*)g.A + (size_t)cur.pm * tstep; const char* cB = (const char*)g.Bt + (size_t)cur.pn * tstep;
    S.a_ready(cur);
    if constexpr (SP2) {
        PG8_STAGE(PG8_SB(0, 0), cB, voffB); PG8_STAGE(PG8_SB(0, 1), cB + hstep, voffB); PG8_STAGE(PG8_SA(0, 0), cA, voffA); PG8_STAGE(PG8_SA(0, 1), cA + hstep, voffA);
        if (wr == 1) PG8_BAR;
        PG8_WAIT_V(2); PG8_BAR;
        PG8_STAGE(PG8_SB(1, 0), cB + kstep, voffB); PG8_STAGE(PG8_SA(1, 0), cA + kstep, voffA); PG8_STAGE(PG8_SB(1, 1), cB + hstep + kstep, voffB);
        PG8_WAIT_V(6); PG8_BAR;
    } else {
        PG8_STAGE(PG8_SB(0, 0), cB, voffB); PG8_STAGE(PG8_SA(0, 0), cA, voffA); PG8_STAGE(PG8_SB(0, 1), cB + hstep, voffB); PG8_STAGE(PG8_SA(0, 1), cA + hstep, voffA);
        if (wr == 1) PG8_BAR;
        PG8_WAIT_V(4); PG8_BAR;
        PG8_STAGE(PG8_SB(1, 0), cB + kstep, voffB); PG8_STAGE(PG8_SA(1, 0), cA + kstep, voffA); PG8_STAGE(PG8_SB(1, 1), cB + hstep + kstep, voffB);
        PG8_WAIT_V(6); PG8_BAR;
    }
    for (;;) {
        const bool has_next = S.next(ui + 1, nxt);
        const char* nA = has_next ? (const char*)g.A + (size_t)nxt.pm * tstep : cA; const char* nB = has_next ? (const char*)g.Bt + (size_t)nxt.pn * tstep : cB;
        for (int t = 0; t < nt; t += 2) {
            const bool last = (t == nt - 2);
            const char* a1 = cA + (size_t)(t + 1) * kstep;
            const char* a2 = last ? nA : cA + (size_t)(t + 2) * kstep; const char* b2 = last ? nB : cB + (size_t)(t + 2) * kstep;
            const char* a3 = a2 + kstep; const char* b3 = b2 + kstep;
            if (last && has_next) S.a_ready(nxt);
            if constexpr (SP2) {
            PG8_LDB(B0, 0, 0); PG8_LDB(B1, 0, 1); PG8_SCHED; PG8_LDA(At, 0, 0); PG8_STAGE(PG8_SA(1, 1), a1 + hstep, voffA);
            PG8_WAIT_V(8); PG8_WAIT_L(0); PG8_BAR; PG8_MMA(0, 0, At, B0); PG8_MMA(0, 1, At, B1); PG8_BAR; PG8_SCHED;
            PG8_LDA(At, 0, 1); PG8_STAGE(PG8_SB(0, 0), b2, voffB); PG8_STAGE(PG8_SB(0, 1), b2 + hstep, voffB); PG8_STAGE(PG8_SA(0, 0), a2, voffA);
            PG8_WAIT_V(8); PG8_WAIT_L(0); PG8_BAR; PG8_MMA(1, 0, At, B0); PG8_MMA(1, 1, At, B1); PG8_BAR; PG8_SCHED;
            PG8_LDB(B0, 1, 0); PG8_LDB(B1, 1, 1); PG8_SCHED; PG8_LDA(At, 1, 0); PG8_STAGE(PG8_SA(0, 1), a2 + hstep, voffA);
            PG8_WAIT_V(8); PG8_WAIT_L(0); PG8_BAR; PG8_MMA(0, 0, At, B0); PG8_MMA(0, 1, At, B1); PG8_BAR; PG8_SCHED;
            PG8_LDA(At, 1, 1); PG8_STAGE(PG8_SB(1, 0), b3, voffB); PG8_STAGE(PG8_SB(1, 1), b3 + hstep, voffB); PG8_STAGE(PG8_SA(1, 0), a3, voffA);
            PG8_WAIT_V(8); PG8_WAIT_L(0); PG8_BAR; PG8_MMA(1, 0, At, B0); PG8_MMA(1, 1, At, B1); PG8_BAR; PG8_SCHED;
            } else {
            PG8_LDB(B0, 0, 0); PG8_SCHED; PG8_LDA(At, 0, 0); PG8_STAGE(PG8_SA(1, 1), a1 + hstep, voffA);
            PG8_WAIT_L(8); PG8_BAR; PG8_WAIT_L(0); PG8_MMA(0, 0, At, B0); PG8_BAR; PG8_SCHED;
            PG8_LDB(B1, 0, 1); PG8_STAGE(PG8_SB(0, 0), b2, voffB);
            PG8_BAR; PG8_WAIT_L(0); PG8_MMA(0, 1, At, B1); PG8_BAR;
            PG8_LDA(At, 0, 1); PG8_STAGE(PG8_SA(0, 0), a2, voffA);
            PG8_BAR; PG8_WAIT_L(0); PG8_MMA(1, 0, At, B0); PG8_BAR; PG8_SCHED;
            PG8_STAGE(PG8_SB(0, 1), b2 + hstep, voffB);
            PG8_WAIT_V(6); PG8_BAR; PG8_MMA(1, 1, At, B1); PG8_BAR;
            PG8_LDB(B0, 1, 0); PG8_SCHED; PG8_LDA(At, 1, 0); PG8_STAGE(PG8_SA(0, 1), a2 + hstep, voffA);
            PG8_WAIT_L(8); PG8_BAR; PG8_WAIT_L(0); PG8_MMA(0, 0, At, B0); PG8_BAR; PG8_SCHED;
            PG8_LDB(B1, 1, 1); PG8_STAGE(PG8_SB(1, 0), b3, voffB);
            PG8_BAR; PG8_WAIT_L(0); PG8_MMA(0, 1, At, B1); PG8_BAR;
            PG8_LDA(At, 1, 1); PG8_STAGE(PG8_SA(1, 0), a3, voffA);
            PG8_BAR; PG8_WAIT_L(0); PG8_MMA(1, 0, At, B0); PG8_BAR; PG8_SCHED;
            PG8_STAGE(PG8_SB(1, 1), b3 + hstep, voffB);
            PG8_WAIT_V(6); PG8_BAR; PG8_MMA(1, 1, At, B1); PG8_BAR;
            }
        }
        if constexpr (ALIGN_EPI) { if (wr == 0) PG8_BAR; }
        if constexpr (!Epi::AFTER_DRAIN) { E(acc, cur, wr, wc, fr, fq); S.done(cur); }
        if (!has_next) break;
#pragma unroll
        for (int a = 0; a < 2; ++a)
#pragma unroll
            for (int b = 0; b < 2; ++b)
#pragma unroll
                for (int m = 0; m < 4; ++m)
#pragma unroll
                    for (int n = 0; n < 2; ++n) acc[a][b][m][n] = (f32x4){0.f, 0.f, 0.f, 0.f};
        cur = nxt; cA = nA; cB = nB; ++ui;
        if constexpr (ALIGN_EPI) { if (wr == 1) PG8_BAR; }
    }
    PG8_WAIT_V(0);
    if constexpr (!ALIGN_EPI) { if (wr == 0) PG8_BAR; }
    PG8_BAR;
#undef PG8_SA
#undef PG8_SB
#undef PG8_STAGE
#undef PG8_LDA
#undef PG8_LDB
#undef PG8_MMA
#undef PG8_WAIT_V
#undef PG8_WAIT_L
#undef PG8_BAR
#undef PG8_SCHED
}
}
#endif

#ifndef EMU
#define LAS __attribute__((address_space(3)))
#define XB_TMO      128
#define XB_XCNT(j)  (256  + 64 * (j))
#define XB_XSUB(j)  (1280 + 64 * (j))
#define XB_XGEN(j)  (2304 + 64 * (j))
#define XB_TOP      3328
#define XB_TOPGEN   3392
#define XCD_BAR_WORDS 3456
#define XB_SPIN_CAP (1u << 18)
__device__ __forceinline__ unsigned xb_ld(unsigned* p)              { return __hip_atomic_load(p, __ATOMIC_RELAXED, __HIP_MEMORY_SCOPE_AGENT); }
__device__ __forceinline__ unsigned xb_add(unsigned* p, unsigned v) { return __hip_atomic_fetch_add(p, v, __ATOMIC_RELAXED, __HIP_MEMORY_SCOPE_AGENT); }
__device__ __forceinline__ unsigned xb_xcc_id() { return (unsigned)__builtin_amdgcn_s_getreg((3 << 11) | 20) & 0xFu; }
#define XB_SPIN(cond, bar) do { unsigned _sp = 0; while (cond) { __builtin_amdgcn_s_sleep(1); \
    if ((++_sp & 255u) == 0u) { if (xb_ld(&(bar)[XB_TMO])) break; if (_sp > XB_SPIN_CAP) { atomicAdd(&(bar)[XB_TMO], 1u); break; } } } } while (0)
struct XcdBarrier { unsigned* bar; unsigned x; volatile LAS unsigned* st; };
__device__ __forceinline__ XcdBarrier xcd_barrier_post(unsigned* bar, volatile LAS unsigned* st) {
    XcdBarrier b; b.bar = bar; b.x = xb_xcc_id(); b.st = st;
    if (threadIdx.x == 0) (void)xb_add(&bar[XB_XCNT(b.x)], 1u);
    return b;
}
__device__ __forceinline__ void xcd_barrier_complete(unsigned* bar, unsigned x, unsigned& nloc, unsigned& nx) {
    const unsigned G = gridDim.x * gridDim.y * gridDim.z;
    unsigned sum, cnt, mine, sp = 0u;
    for (;;) {
        sum = 0u; cnt = 0u; mine = 0u;
#pragma unroll
        for (unsigned j = 0; j < 16; ++j) { const unsigned c = xb_ld(&bar[XB_XCNT(j)]); sum += c; cnt += (c > 0u) ? 1u : 0u; mine = (j == x) ? c : mine; }
        if (sum == G) break;
        __builtin_amdgcn_s_sleep(1);
        if ((++sp & 255u) == 0u) { if (xb_ld(&bar[XB_TMO])) break; if (sp > XB_SPIN_CAP) { atomicAdd(&bar[XB_TMO], 1u); break; } }
    }
    nloc = mine > 0u ? mine : 1u; nx = cnt > 0u ? cnt : 1u;
}
__device__ __forceinline__ void xcd_barrier(const XcdBarrier& b) {
    asm volatile("s_waitcnt vmcnt(0)" ::: "memory");
    __syncthreads();
    if (threadIdx.x == 0) {
        unsigned* bar = b.bar;
        __builtin_amdgcn_s_waitcnt(0);
        unsigned nloc = b.st[0], nx = b.st[1];
        if (nloc == 0u) { xcd_barrier_complete(bar, b.x, nloc, nx); b.st[0] = nloc; b.st[1] = nx; }
        const unsigned old = xb_add(&bar[XB_XSUB(b.x)], 1u);
        const unsigned gen = old / nloc;
        if (old + 1u == (gen + 1u) * nloc) {
            __builtin_amdgcn_fence(__ATOMIC_RELEASE, "agent");
            asm volatile("s_waitcnt vmcnt(0)" ::: "memory");
            const unsigned og = xb_add(&bar[XB_TOP], 1u);
            const unsigned tg = og / nx;
            if (og + 1u == (tg + 1u) * nx) xb_add(&bar[XB_TOPGEN], 1u);
            else XB_SPIN(xb_ld(&bar[XB_TOPGEN]) == tg, bar);
            __builtin_amdgcn_fence(__ATOMIC_ACQUIRE, "agent");
            xb_add(&bar[XB_XGEN(b.x)], 1u);
            asm volatile("s_waitcnt vmcnt(0)" ::: "memory");
        } else {
            XB_SPIN(xb_ld(&bar[XB_XGEN(b.x)]) == gen, bar);
            __builtin_amdgcn_fence(__ATOMIC_ACQUIRE, "agent");
            asm volatile("s_waitcnt vmcnt(0)" ::: "memory");
        }
    }
    __syncthreads();
}
constexpr int RING_BYTES = 131072, MISC_OFF = RING_BYTES + 320, LDS_BYTES = 147456;
constexpr int CW_BAR = 4096;
#endif

#ifndef PHASE_MASK
#define PHASE_MASK 0xFFFF
#endif
#define PM(k) ((PHASE_MASK >> (k)) & 1)
#ifdef EMU
typedef const Params* ArgPtr;
DEV Params load_params(ArgPtr a) { return *a; }
#else
struct Args { Params p; int ph_lo, ph_hi, li, pad; };
typedef const __attribute__((address_space(4))) Args* ArgPtr;
DEV Params load_params(ArgPtr ap) { Params p;
#pragma unroll
    for (int i = 0; i < 22; ++i) p.in[i] = ap->p.in[i];
    p.out = ap->p.out; p.ws = ap->p.ws; return p; }
#endif
DEV void run_one_phase(ArgPtr ap, int ph) {
    if (ph == 0) { if (PM(0)) { const Params p = load_params(ap); phase_prologue(p); } return; }
    const int l = (ph - PH_L0) / PH_PER_LAYER, r = (ph - PH_L0) % PH_PER_LAYER;
    if (PM(1) && (r == 0 || r == 9)) {
        const Params p = load_params(ap);
        const int f = (r == 9) ? 1 : 0;
#ifdef EMU
        emu_gemm_up(p, l, f);
#else
        pg8::Gemm g{(const pg8::bf16_t*)(p.ws + WS_XB), W13T(p, l, f), M, 2 * DFF, D}; pg8::StaticOrder S; S.init(M, 2 * DFF, nblk(), bid());
        pg8::EpiSwiGLU E{(pg8::bf16_t*)(p.ws + WS_HZ)};
        pg8::gemm_phase<pg8::EpiSwiGLU, pg8::StaticOrder, true, true>((PG8_LAS unsigned char*)dyn_lds, g, S, E);
#endif
    } else if (PM(2) && (r == 1 || r == 10 || r == 7)) {
        const Params p = load_params(ap);
        const int f = (r == 10) ? 1 : 0;
        const unsigned short* A = (r == 7) ? (const unsigned short*)(p.ws + WS_XB) : (const unsigned short*)(p.ws + WS_HZ);
        const unsigned short* Bt = (r == 7) ? WOUTT(p, l) : W2T(p, l, f);
        const int K = (r == 7) ? D : DFF;
        const float* base = (l == 0 && r == 1) ? p.in[0] : p.out;
        const float coef = (r == 7) ? 1.0f : 0.5f;
#ifdef EMU
        emu_gemm_resid(p, A, Bt, K, base, ALPHA, coef);
#else
        pg8::Gemm g{A, Bt, M, D, K}; pg8::StaticOrder S; S.init(M, D, nblk(), bid());
        pg8::EpiResid E{base, p.out, ALPHA, coef};
        pg8::gemm_phase<pg8::EpiResid, pg8::StaticOrder, true, true>((PG8_LAS unsigned char*)dyn_lds, g, S, E);
#endif
    } else if (PM(3) && (r == 2 || r == 8 || r == 11)) {
        const Params p = load_params(ap);
        phase_ln(p, l, r == 2 ? 0 : (r == 8 ? 1 : 2));
    } else if (PM(4) && r == 3) {
        const Params p = load_params(ap);
#ifdef EMU
        emu_gemm_z(p, l);
#else
        pg8::Gemm g{(const pg8::bf16_t*)(p.ws + WS_XB), WINT(p, l), M, NINP, D}; pg8::StaticOrder S; S.init(M, NINP, nblk(), bid());
        pg8::EpiZ E{(pg8::bf16_t*)(p.ws + WS_HZ), (float*)(p.ws + WS_GF)};
        pg8::gemm_phase<pg8::EpiZ, pg8::StaticOrder, true, true>((PG8_LAS unsigned char*)dyn_lds, g, S, E);
#endif
    } else if (PM(5) && r == 4) { const Params p = load_params(ap); phase_m1(p, l); }
    else if (PM(6) && r == 5) { const Params p = load_params(ap); phase_m1b(p); }
    else if (PM(7) && r == 6) { const Params p = load_params(ap); phase_m2(p, l); }
}

#ifdef EMU
static void run_phases(const Params& p, int lo, int hi) { for (int ph = lo; ph < hi; ++ph) run_one_phase(&p, ph); }
#else
__global__ void __launch_bounds__(512, 2) mega_fwd(Args a) {
    volatile LAS unsigned* MISC = (volatile LAS unsigned*)((LAS unsigned char*)dyn_lds + MISC_OFF);
    for (int u = threadIdx.x; u < (LDS_BYTES - RING_BYTES) / 4; u += 512) ((LAS unsigned*)((LAS unsigned char*)dyn_lds + RING_BYTES))[u] = 0u;
    __syncthreads();
    unsigned* barw = (unsigned*)(a.p.ws) + CW_BAR + a.li * XCD_BAR_WORDS;
    XcdBarrier bar; bar.bar = barw; bar.x = 0; bar.st = nullptr;
    if (a.ph_hi - a.ph_lo > 1) bar = xcd_barrier_post(barw, MISC + 8);
    const int ph_lo = a.ph_lo, ph_hi = a.ph_hi;
    for (int ph = ph_lo; ph < ph_hi; ++ph) {
        ArgPtr ap = (ArgPtr)__builtin_amdgcn_kernarg_segment_ptr();
        asm volatile("" : "+s"(ap));
        run_one_phase(ap, ph);
        if (ph + 1 < ph_hi) xcd_barrier(bar);
    }
}

extern "C" void kernel_launch(void* const* d_in, const int* in_sizes, int n_in, void* d_out, int out_size, void* d_ws, size_t ws_size, hipStream_t stream) {
    static int grid = 0;
    if (grid == 0) {
        if (n_in != 22 || in_sizes[0] != M * D || out_size != M * D || ws_size < WS_TOTAL) { fprintf(stderr, "kernel_launch: unexpected shapes (n_in %d, in0 %d, out %d, ws %zu < %zu)\n", n_in, n_in > 0 ? in_sizes[0] : -1, out_size, ws_size, (size_t)WS_TOTAL); grid = -1; return; }
        int dev = 0, cus = 0, per_cu = 0;
        if (hipGetDevice(&dev) != hipSuccess || hipDeviceGetAttribute(&cus, hipDeviceAttributeMultiprocessorCount, dev) != hipSuccess) { grid = -1; return; }
        if (hipFuncSetAttribute((const void*)mega_fwd, hipFuncAttributeMaxDynamicSharedMemorySize, LDS_BYTES) != hipSuccess) { fprintf(stderr, "kernel_launch: hipFuncSetAttribute failed\n"); grid = -1; return; }
        if (hipOccupancyMaxActiveBlocksPerMultiprocessor(&per_cu, (const void*)mega_fwd, 512, LDS_BYTES) != hipSuccess || per_cu < 1) fprintf(stderr, "kernel_launch: occupancy query reports %d blocks per CU\n", per_cu);
        (void)hipGetLastError();
        grid = cus;
    }
    if (grid < 0) return;
    if (hipMemsetAsync(d_ws, 0, CTL_BYTES, stream) != hipSuccess) return;
    Args a{};
    for (int i = 0; i < 22; ++i) a.p.in[i] = (const float*)d_in[i];
    a.p.out = (float*)d_out; a.p.ws = (unsigned char*)d_ws;
#if MK_N_LAUNCHES == 1
    a.ph_lo = 0; a.ph_hi = NPHASES; a.li = 0;
    hipLaunchKernelGGL(mega_fwd, dim3(grid), dim3(512), LDS_BYTES, stream, a);
#else
    for (int ph = 0; ph < NPHASES; ++ph) { a.ph_lo = ph; a.ph_hi = ph + 1; a.li = 0; hipLaunchKernelGGL(mega_fwd, dim3(grid), dim3(512), LDS_BYTES, stream, a); }
#endif
}
#endif
```

```cpp
#ifndef EMU
#include <hip/hip_runtime.h>
#include <cstdio>
#include <cstdint>
#include <cmath>
#define DEV __device__ __forceinline__
#else
#define DEV static inline
#endif

#ifndef CFG_B
#define CFG_B 8
#endif
#ifndef CFG_S
#define CFG_S 2048
#endif
#ifndef MK_N_LAUNCHES
#define MK_N_LAUNCHES 1
#endif

typedef short bf16x8 __attribute__((ext_vector_type(8)));
typedef short bf16x4 __attribute__((ext_vector_type(4)));
typedef float f32x16 __attribute__((ext_vector_type(16)));
typedef float f32x4 __attribute__((ext_vector_type(4)));
typedef unsigned u32x4 __attribute__((ext_vector_type(4)));
typedef unsigned u32x2 __attribute__((ext_vector_type(2)));

constexpr int NB = CFG_B, SEQ = CFG_S, M = NB * SEQ, D = 1024, DFF = 2816, NIN = 2728, NINP = 2816, DEPTH = 2;
constexpr int NC = SEQ / 64, NLC = SEQ / 32, NQ = SEQ / 64;
constexpr float ALPHA = 1.41421356237309505f;
constexpr float LOG2E = 1.4426950408889634f;
constexpr int ZC_CQ = 0, ZC_CKV = 256, ZC_KR = 384, ZC_LX = 416, ZC_LG = 672, ZC_SQ = 928, ZC_SK = 1184, ZC_SV = 1440, ZC_MQ = 1696, ZC_MK = 1952, ZC_MV = 2208, ZC_MO = 2464, ZC_MI = 2720;
constexpr int PH_L0 = 1, PH_PER_LAYER = 12, NPHASES = 1 + DEPTH * PH_PER_LAYER;

constexpr size_t al256(size_t x) { return (x + 255) & ~(size_t)255; }
constexpr size_t CTL_BYTES = 1u << 20;
constexpr size_t SZ_W13 = (size_t)2 * DFF * D * 2, SZ_W2 = (size_t)D * DFF * 2, SZ_WIN = (size_t)NINP * D * 2, SZ_WOUT = (size_t)D * D * 2;
constexpr size_t SZ_WUQ = 384 * 256 * 2, SZ_WUKV = 512 * 128 * 2, SZ_WLRU = 4 * 64 * 64 * 2, SZ_ROPE = (size_t)SEQ * 16 * 4;
constexpr size_t WS_W13 = CTL_BYTES;
constexpr size_t WS_W2 = WS_W13 + 4 * SZ_W13;
constexpr size_t WS_WIN = WS_W2 + 4 * SZ_W2;
constexpr size_t WS_WOUT = WS_WIN + 2 * SZ_WIN;
constexpr size_t WS_WUQ = WS_WOUT + 2 * SZ_WOUT;
constexpr size_t WS_WUKV = WS_WUQ + 2 * SZ_WUQ;
constexpr size_t WS_WLRU = WS_WUKV + 2 * SZ_WUKV;
constexpr size_t WS_ROPE = WS_WLRU + 4 * SZ_WLRU;
constexpr size_t WS_SP = WS_ROPE + 2 * SZ_ROPE;
constexpr size_t WS_XB = al256(WS_SP + DEPTH * 256 * 4);
constexpr size_t WS_HZ = WS_XB + (size_t)M * D * 2;
constexpr size_t WS_QM = WS_HZ + (size_t)M * NINP * 2;
constexpr size_t WS_KM = WS_QM + (size_t)M * 384 * 2;
constexpr size_t WS_VM = WS_KM + (size_t)M * 384 * 2;
constexpr size_t WS_GF = WS_VM + (size_t)M * 256 * 2;
constexpr size_t WS_CT = WS_GF + (size_t)M * 8 * 4;
constexpr size_t WS_NU = WS_CT + (size_t)NB * 4 * NC * 4096 * 4;
constexpr size_t WS_AG = WS_NU + (size_t)NB * 4 * NC * 64 * 4;
constexpr size_t WS_MS = WS_AG + (size_t)NB * 4 * NC * 2 * 4;
constexpr size_t WS_LAC = al256(WS_MS + (size_t)NB * 4 * NC * 4);
constexpr size_t WS_LHC = WS_LAC + (size_t)NB * NLC * 256 * 4;
constexpr size_t WS_LCR = WS_LHC + (size_t)NB * NLC * 256 * 4;
constexpr size_t WS_TOTAL = WS_LCR + (size_t)NB * NLC * 256 * 4;
static_assert(WS_TOTAL <= (size_t)256 * 1024 * 1024, "workspace map exceeds 256 MiB");

struct Params { const float* in[22]; float* out; unsigned char* ws; };
#ifndef UNIT_MASK
#define UNIT_MASK 0xFFFF
#endif
#define UM(k) ((UNIT_MASK >> (k)) & 1)

#ifndef EMU
extern __shared__ __attribute__((aligned(16))) unsigned char dyn_lds[];
DEV int tid() { int t = (int)threadIdx.x; asm volatile("" : "+v"(t)); return t; }
DEV int bid() { int b = (int)blockIdx.x; asm volatile("" : "+s"(b)); return b; }
DEV int nblk() { return (int)gridDim.x; }
DEV void bsync() { __syncthreads(); }
DEV void wsync() { asm volatile("s_waitcnt lgkmcnt(0)" ::: "memory"); }
DEV unsigned char* lds_base() { return dyn_lds; }
DEV f32x16 mfma32(bf16x8 a, bf16x8 b, f32x16 c) { return __builtin_amdgcn_mfma_f32_32x32x16_bf16(a, b, c, 0, 0, 0); }
DEV float bperm(int src_lane, float v) { return __builtin_bit_cast(float, __builtin_amdgcn_ds_bpermute(src_lane << 2, __builtin_bit_cast(int, v))); }
DEV float shfl_xor(float v, int m) { return bperm((tid() & 63) ^ m, v); }
DEV float shfl_up(float v, int d) { const int l = tid() & 63; return bperm(l >= d ? l - d : l, v); }
DEV float shfl_idx(float v, int s) { return bperm(s & 63, v); }
DEV float ex2(float x) { return __builtin_amdgcn_exp2f(x); }
DEV float rcpf(float x) { return __builtin_amdgcn_rcpf(x); }
DEV float rsqf(float x) { return __builtin_amdgcn_rsqf(x); }
DEV float lg2(float x) { return __builtin_amdgcn_logf(x); }
DEV float sin_rev(float x) { return __builtin_amdgcn_sinf(x); }
DEV float cos_rev(float x) { return __builtin_amdgcn_cosf(x); }
#endif

#ifdef EMU
DEV unsigned short f2bf(float f) { unsigned u = __builtin_bit_cast(unsigned, f); u += 0x7fffu + ((u >> 16) & 1u); return (unsigned short)(u >> 16); }
DEV unsigned pk2(float lo, float hi) { return (unsigned)f2bf(lo) | ((unsigned)f2bf(hi) << 16); }
#else
typedef float f32x2_t __attribute__((ext_vector_type(2))); typedef __bf16 bf16x2_t __attribute__((ext_vector_type(2)));
DEV unsigned pk2(float lo, float hi) { f32x2_t v = {lo, hi}; bf16x2_t b = __builtin_convertvector(v, bf16x2_t); return __builtin_bit_cast(unsigned, b); }
DEV unsigned short f2bf(float f) { return (unsigned short)(pk2(f, 0.f) & 0xffffu); }
#endif
DEV float bf2f(unsigned short h) { return __builtin_bit_cast(float, (unsigned)h << 16); }
DEV float bfs2f(short h) { return bf2f((unsigned short)h); }
DEV int crow(int reg, int hi) { return (reg & 3) + 8 * (reg >> 2) + 4 * hi; }
DEV float sigmoidf_(float x) { return rcpf(1.0f + ex2(-x * LOG2E)); }
DEV float fexp(float x) { return ex2(x * LOG2E); }
DEV float log1p_fast(float x) {
    const float s = x * (1.0f - x * (0.5f - x * (0.33333333f - 0.25f * x))), g = lg2(1.0f + x) * 0.6931471805599453f;
    return x < 0.03f ? s : g;
}
DEV float wave_sum(float v) {
#pragma unroll
    for (int o = 1; o < 64; o <<= 1) v += shfl_xor(v, o);
    return v;
}
DEV float wave_max(float v) {
#pragma unroll
    for (int o = 1; o < 64; o <<= 1) v = fmaxf(v, shfl_xor(v, o));
    return v;
}
DEV bf16x8 pack8(float a0, float a1, float a2, float a3, float a4, float a5, float a6, float a7) {
    u32x4 w; w.x = pk2(a0, a1); w.y = pk2(a2, a3); w.z = pk2(a4, a5); w.w = pk2(a6, a7); return __builtin_bit_cast(bf16x8, w);
}

DEV unsigned short* W13T(const Params& p, int l, int f) { return (unsigned short*)(p.ws + WS_W13 + (size_t)(l * 2 + f) * SZ_W13); }
DEV unsigned short* W2T(const Params& p, int l, int f) { return (unsigned short*)(p.ws + WS_W2 + (size_t)(l * 2 + f) * SZ_W2); }
DEV unsigned short* WINT(const Params& p, int l) { return (unsigned short*)(p.ws + WS_WIN + (size_t)l * SZ_WIN); }
DEV unsigned short* WOUTT(const Params& p, int l) { return (unsigned short*)(p.ws + WS_WOUT + (size_t)l * SZ_WOUT); }
DEV unsigned short* WUQT(const Params& p, int l) { return (unsigned short*)(p.ws + WS_WUQ + (size_t)l * SZ_WUQ); }
DEV unsigned short* WUKVT(const Params& p, int l) { return (unsigned short*)(p.ws + WS_WUKV + (size_t)l * SZ_WUKV); }
DEV unsigned short* WLRUT(const Params& p, int l, int gate) { return (unsigned short*)(p.ws + WS_WLRU + (size_t)(l * 2 + gate) * SZ_WLRU); }

DEV void transpose_item(const float* W, int ldw, int nvalid, const float* kscale, unsigned short* WT, int ldk, int dst_row0, int k0, int n0, float* scr, int lane) {
#pragma unroll
    for (int hb = 0; hb < 2; ++hb) {
        float vv[16];
#pragma unroll
        for (int i = 0; i < 16; ++i) { const int kk = 2 * (16 * hb + i) + (lane >> 5), n = n0 + (lane & 31); vv[i] = (n < nvalid) ? W[(size_t)(k0 + kk) * ldw + n] : 0.f; }
#pragma unroll
        for (int i = 0; i < 16; ++i) { const int kk = 2 * (16 * hb + i) + (lane >> 5); float v = vv[i]; if (kscale) v *= kscale[k0 + kk]; scr[kk * 33 + (lane & 31)] = v; }
    }
    wsync();
    const int c = lane & 7;
#pragma unroll
    for (int j = 0; j < 4; ++j) {
        const int n = (lane >> 3) + 8 * j; const float* s = scr + (8 * c) * 33 + n;
        u32x4 o; o.x = pk2(s[0 * 33], s[1 * 33]); o.y = pk2(s[2 * 33], s[3 * 33]); o.z = pk2(s[4 * 33], s[5 * 33]); o.w = pk2(s[6 * 33], s[7 * 33]);
        *(u32x4*)(WT + (size_t)(dst_row0 + n) * ldk + k0 + 8 * c) = o;
    }
    wsync();
}
constexpr int IT_FFN = 1408, IT_LAYER = 6 * IT_FFN + 1408 + 512 + 48 + 32 + 16;
DEV void phase_prologue(const Params& p) {
    const int t = tid(), lane = t & 63, w = t >> 6;
    float* scr = (float*)(lds_base() + w * 16384);
    const int gw = bid() * 8 + w, NGW = nblk() * 8;
    for (int it = gw; it < DEPTH * IT_LAYER; it += NGW) {
        const int l = it / IT_LAYER; int r = it % IT_LAYER;
        if (r < 6 * IT_FFN) {
            const int fk = r / IT_FFN, f = fk / 3, kind = fk % 3, q = r % IT_FFN;
            if (kind < 2) {
                const int kb = q / 88, nbk = q % 88, n0 = 32 * nbk;
                transpose_item((kind ? p.in[4] : p.in[3]) + (size_t)(l * 2 + f) * D * DFF, DFF, DFF, nullptr, W13T(p, l, f), D, (n0 / 128) * 256 + kind * 128 + (n0 % 128), 64 * kb, n0, scr, lane);
            } else {
                const int kb = q / 32, nbk = q % 32, n0 = 32 * nbk;
                transpose_item(p.in[5] + (size_t)(l * 2 + f) * DFF * D, D, D, nullptr, W2T(p, l, f), DFF, n0, 64 * kb, n0, scr, lane);
            }
            continue;
        }
        r -= 6 * IT_FFN;
        if (r < 1408) { const int kb = r / 88, n0 = 32 * (r % 88); transpose_item(p.in[6] + (size_t)l * D * NIN, NIN, NIN, nullptr, WINT(p, l), D, n0, 64 * kb, n0, scr, lane); continue; }
        r -= 1408;
        if (r < 512) { const int kb = r / 32, n0 = 32 * (r % 32); transpose_item(p.in[21] + (size_t)l * D * D, D, D, nullptr, WOUTT(p, l), D, n0, 64 * kb, n0, scr, lane); continue; }
        r -= 512;
        if (r < 48) { const int kb = r / 12, n0 = 32 * (r % 12); transpose_item(p.in[9] + (size_t)l * 256 * 384, 384, 384, p.in[7] + l * 256, WUQT(p, l), 256, n0, 64 * kb, n0, scr, lane); continue; }
        r -= 48;
        if (r < 32) { const int kb = r / 16, n0 = 32 * (r % 16); transpose_item(p.in[10] + (size_t)l * 128 * 512, 512, 512, p.in[8] + l * 128, WUKVT(p, l), 128, n0, 64 * kb, n0, scr, lane); continue; }
        r -= 32;
        { const int gate = r / 8, h = (r % 8) / 2, n0 = 32 * (r % 2);
          transpose_item((gate ? p.in[15] : p.in[13]) + (size_t)(l * 4 + h) * 4096, 64, 64, nullptr, WLRUT(p, l, gate) + h * 4096, 64, n0, 0, n0, scr, lane); }
    }
    unsigned short* XB = (unsigned short*)(p.ws + WS_XB);
    for (int m = gw; m < M; m += NGW) {
        const float* xr = p.in[0] + (size_t)m * D;
#pragma unroll
        for (int j = 0; j < 4; ++j) { const f32x4 v = *(const f32x4*)(xr + 4 * lane + 256 * j); u32x2 o; o.x = pk2(v.x, v.y); o.y = pk2(v.z, v.w); *(u32x2*)(XB + (size_t)m * D + 4 * lane + 256 * j) = o; }
    }
    float* COS = (float*)(p.ws + WS_ROPE); float* SIN = COS + SEQ * 16;
    for (int idx = bid() * 512 + t; idx < SEQ * 16; idx += nblk() * 512) {
        const int pos = idx >> 4, i = idx & 15;
        const float fr = ex2(-(float)i * 0.83048202372184059f);
        const float a = (float)pos * fr;
        const double rev = (double)a * 0.15915494309189535; const float fx = (float)(rev - (double)(long long)rev);
        COS[idx] = cos_rev(fx); SIN[idx] = sin_rev(fx);
    }
    if (bid() == 0) { const float lam = p.in[17][t]; ((float*)(p.ws + WS_SP))[t] = fmaxf(-lam, 0.f) + log1p_fast(fexp(-fabsf(lam))); }
}

DEV void phase_ln(const Params& p, int l, int j) {
    const float* g = p.in[1] + (size_t)(l * 3 + j) * D; const float* bb = p.in[2] + (size_t)(l * 3 + j) * D;
    unsigned short* XB = (unsigned short*)(p.ws + WS_XB);
    const int t = tid(), lane = t & 63, gw = bid() * 8 + (t >> 6), NGW = nblk() * 8;
    for (int m = gw; m < M; m += NGW) {
        float* xr = p.out + (size_t)m * D; f32x4 v[4]; float s = 0.f;
#pragma unroll
        for (int q = 0; q < 4; ++q) { v[q] = *(const f32x4*)(xr + 4 * lane + 256 * q); s += (v[q].x + v[q].y) + (v[q].z + v[q].w); }
        const float mean = wave_sum(s) * (1.f / D); float s2 = 0.f;
#pragma unroll
        for (int q = 0; q < 4; ++q) { v[q] = v[q] - mean; s2 += (v[q].x * v[q].x + v[q].y * v[q].y) + (v[q].z * v[q].z + v[q].w * v[q].w); }
        const float rstd = 1.0f / sqrtf(wave_sum(s2) * (1.f / D) + 1e-5f);
#pragma unroll
        for (int q = 0; q < 4; ++q) {
            const f32x4 gg = *(const f32x4*)(g + 4 * lane + 256 * q), b4 = *(const f32x4*)(bb + 4 * lane + 256 * q);
            const f32x4 o = v[q] * rstd * gg + b4;
            *(f32x4*)(xr + 4 * lane + 256 * q) = o;
            u32x2 ob; ob.x = pk2(o.x, o.y); ob.y = pk2(o.z, o.w); *(u32x2*)(XB + (size_t)m * D + 4 * lane + 256 * q) = ob;
        }
    }
}

DEV void mla_prep_unit(const Params& p, int l, int u) {
    const int t = tid(), lane = t & 63, w = t >> 6, r32 = lane & 31, hi = lane >> 5, tb = w & 1, sub = w >> 1;
    const size_t row = (size_t)u * 64 + 32 * tb + r32;
    const int pos = (int)(row % SEQ);
    const unsigned short* zr = (const unsigned short*)(p.ws + WS_HZ) + row * NINP;
    unsigned short* QM = (unsigned short*)(p.ws + WS_QM) + row * 384;
    unsigned short* KM = (unsigned short*)(p.ws + WS_KM) + row * 384;
    unsigned short* VM = (unsigned short*)(p.ws + WS_VM) + row * 256;
    const float* COS = (const float*)(p.ws + WS_ROPE) + pos * 16; const float* SIN = COS + SEQ * 16;
    bf16x8 cq[16]; float sq = 0.f;
#pragma unroll
    for (int ks = 0; ks < 16; ++ks) { cq[ks] = *(const bf16x8*)(zr + ZC_CQ + 16 * ks + 8 * hi);
#pragma unroll
        for (int j = 0; j < 8; ++j) { const float f = bfs2f(cq[ks][j]); sq += f * f; } }
    sq += shfl_xor(sq, 32); const float rq = 1.0f / sqrtf(sq * (1.f / 256.f) + 1e-6f);
    bf16x8 ck[8]; float sk = 0.f;
#pragma unroll
    for (int ks = 0; ks < 8; ++ks) { ck[ks] = *(const bf16x8*)(zr + ZC_CKV + 16 * ks + 8 * hi);
#pragma unroll
        for (int j = 0; j < 8; ++j) { const float f = bfs2f(ck[ks][j]); sk += f * f; } }
    sk += shfl_xor(sk, 32); const float rk = 1.0f / sqrtf(sk * (1.f / 128.f) + 1e-6f);
    const unsigned short* Wq = WUQT(p, l); const unsigned short* Wkv = WUKVT(p, l);
#pragma unroll 1
    for (int part = 0; part < 3; ++part) {
        f32x16 acc = {};
        const unsigned short* wr = Wq + (size_t)(96 * sub + 32 * part + r32) * 256 + 8 * hi;
#pragma unroll
        for (int ks = 0; ks < 16; ++ks) acc = mfma32(*(const bf16x8*)(wr + 16 * ks), cq[ks], acc);
        acc = acc * rq;
        if (part == 2) {
#pragma unroll
            for (int reg = 0; reg < 8; ++reg) { const int i = crow(reg, hi); const float c = COS[i], s = SIN[i], x1 = acc[reg], x2 = acc[reg + 8]; acc[reg] = x1 * c - x2 * s; acc[reg + 8] = x1 * s + x2 * c; }
        }
#pragma unroll
        for (int g = 0; g < 4; ++g) { u32x2 o; o.x = pk2(acc[4 * g], acc[4 * g + 1]); o.y = pk2(acc[4 * g + 2], acc[4 * g + 3]); *(u32x2*)(QM + 96 * sub + 32 * part + 8 * g + 4 * hi) = o; }
    }
#pragma unroll 1
    for (int kb = 0; kb < 4; ++kb) {
        f32x16 acc = {};
        const unsigned short* wr = Wkv + (size_t)(128 * sub + 32 * kb + r32) * 128 + 8 * hi;
#pragma unroll
        for (int ks = 0; ks < 8; ++ks) acc = mfma32(*(const bf16x8*)(wr + 16 * ks), ck[ks], acc);
        acc = acc * rk;
        unsigned short* dst = (kb < 2) ? (KM + 96 * sub + 32 * kb) : (VM + 64 * sub + 32 * (kb - 2));
#pragma unroll
        for (int g = 0; g < 4; ++g) { u32x2 o; o.x = pk2(acc[4 * g], acc[4 * g + 1]); o.y = pk2(acc[4 * g + 2], acc[4 * g + 3]); *(u32x2*)(dst + 8 * g + 4 * hi) = o; }
    }
    {
        const bf16x8 x1 = *(const bf16x8*)(zr + ZC_KR + 8 * hi), x2 = *(const bf16x8*)(zr + ZC_KR + 16 + 8 * hi);
        float o1[8], o2[8];
#pragma unroll
        for (int j = 0; j < 8; ++j) { const float c = COS[8 * hi + j], s = SIN[8 * hi + j], a = bfs2f(x1[j]), b = bfs2f(x2[j]); o1[j] = a * c - b * s; o2[j] = a * s + b * c; }
        *(bf16x8*)(KM + 96 * sub + 64 + 8 * hi) = pack8(o1[0], o1[1], o1[2], o1[3], o1[4], o1[5], o1[6], o1[7]);
        *(bf16x8*)(KM + 96 * sub + 80 + 8 * hi) = pack8(o2[0], o2[1], o2[2], o2[3], o2[4], o2[5], o2[6], o2[7]);
    }
}

constexpr int LRU_P = 264;
template <int MODE> DEV void lru_unit(const Params& p, int l, int u) {
    const int t = tid(), lane = t & 63, w = t >> 6, r32 = lane & 31, hi = lane >> 5;
    unsigned char* lds = lds_base();
    float* XCf = (float*)lds;
    float* Af = (float*)(lds + 32 * LRU_P * 4);
    unsigned short* XBb = (unsigned short*)(lds + 2 * 32 * LRU_P * 4);
    const unsigned short* Z = (const unsigned short*)(p.ws + WS_HZ);
    const int chk = u % NLC; const size_t rowbase = (size_t)u * 32; const int pos0 = chk * 32;
    {
        const int tt = t >> 4, c0 = (t & 15) * 16;
        float acc[16];
#pragma unroll
        for (int i = 0; i < 16; ++i) acc[i] = p.in[12][l * 256 + c0 + i];
#pragma unroll
        for (int j = 0; j < 4; ++j) {
            const int pp = pos0 + tt - 3 + j;
            if (pp >= 0) {
                const unsigned short* src = Z + (rowbase + tt - 3 + j) * NINP + ZC_LX + c0;
                const bf16x8 x0 = *(const bf16x8*)src, x1 = *(const bf16x8*)(src + 8);
                const float* wj = p.in[11] + (size_t)(l * 4 + j) * 256 + c0;
#pragma unroll
                for (int i = 0; i < 8; ++i) { acc[i] += wj[i] * bfs2f(x0[i]); acc[8 + i] += wj[8 + i] * bfs2f(x1[i]); }
            }
        }
#pragma unroll
        for (int i = 0; i < 16; ++i) { XCf[tt * LRU_P + c0 + i] = acc[i]; XBb[tt * LRU_P + c0 + i] = f2bf(acc[i]); }
    }
    bsync();
    {
        const int h = w >> 1, jh = w & 1;
        f32x16 aa = {}, ax = {};
        const unsigned short* Wa = WLRUT(p, l, 0) + h * 4096 + (32 * jh + r32) * 64 + 8 * hi;
        const unsigned short* Wx = WLRUT(p, l, 1) + h * 4096 + (32 * jh + r32) * 64 + 8 * hi;
#pragma unroll
        for (int ks = 0; ks < 4; ++ks) {
            const bf16x8 bfr = *(const bf16x8*)(XBb + r32 * LRU_P + 64 * h + 16 * ks + 8 * hi);
            aa = mfma32(*(const bf16x8*)(Wa + 16 * ks), bfr, aa);
            ax = mfma32(*(const bf16x8*)(Wx + 16 * ks), bfr, ax);
        }
#pragma unroll
        for (int reg = 0; reg < 16; ++reg) {
            const int ch = 64 * h + 32 * jh + crow(reg, hi);
            const float r = sigmoidf_(aa[reg] + p.in[14][l * 256 + ch]);
            const float ig = sigmoidf_(ax[reg] + p.in[16][l * 256 + ch]);
            const float sp = ((const float*)(p.ws + WS_SP))[l * 256 + ch];
            const float la2 = -8.0f * LOG2E * r * sp;
            const float a = ex2(la2);
            const float xc = XCf[r32 * LRU_P + ch];
            const float uu = sqrtf(fmaxf(1.0f - a * a, 0.f)) * ig * xc;
            Af[r32 * LRU_P + ch] = a; XCf[r32 * LRU_P + ch] = uu;
        }
    }
    bsync();
    if (t < 256) {
        const int ch = t;
        float hh = MODE ? ((const float*)(p.ws + WS_LCR))[(size_t)u * 256 + ch] : 0.f, P = 1.f;
#pragma unroll 8
        for (int tt = 0; tt < 32; ++tt) { const float a = Af[tt * LRU_P + ch], uu = XCf[tt * LRU_P + ch]; hh = a * hh + uu; P *= a; if (MODE) XCf[tt * LRU_P + ch] = hh; }
        if (!MODE) { ((float*)(p.ws + WS_LAC))[(size_t)u * 256 + ch] = P; ((float*)(p.ws + WS_LHC))[(size_t)u * 256 + ch] = hh; }
    }
    bsync();
    if (MODE) {
        const int tt = t >> 4, c0 = (t & 15) * 16; const size_t row = rowbase + tt;
        const unsigned short* gsrc = Z + row * NINP + ZC_LG + c0;
        const bf16x8 g0 = *(const bf16x8*)gsrc, g1 = *(const bf16x8*)(gsrc + 8);
        float y[16], ss = 0.f;
#pragma unroll
        for (int i = 0; i < 16; ++i) {
            const float gx = bfs2f(i < 8 ? g0[i & 7] : g1[i & 7]);
            const float ge = gx * sigmoidf_(1.5957691216057308f * (gx + 0.044715f * gx * gx * gx));
            y[i] = XCf[tt * LRU_P + c0 + i] * ge; ss += y[i] * y[i];
        }
        ss += shfl_xor(ss, 1); ss += shfl_xor(ss, 2); ss += shfl_xor(ss, 4); ss += shfl_xor(ss, 8);
        const float rstd = 1.0f / sqrtf(ss * (1.f / 256.f) + 1e-6f);
        const float* on = p.in[20] + (size_t)l * D + 256 + c0;
        unsigned short* dst = (unsigned short*)(p.ws + WS_XB) + row * D + 256 + c0;
        *(bf16x8*)dst = pack8(y[0] * rstd * on[0], y[1] * rstd * on[1], y[2] * rstd * on[2], y[3] * rstd * on[3], y[4] * rstd * on[4], y[5] * rstd * on[5], y[6] * rstd * on[6], y[7] * rstd * on[7]);
        *(bf16x8*)(dst + 8) = pack8(y[8] * rstd * on[8], y[9] * rstd * on[9], y[10] * rstd * on[10], y[11] * rstd * on[11], y[12] * rstd * on[12], y[13] * rstd * on[13], y[14] * rstd * on[14], y[15] * rstd * on[15]);
        bsync();
    }
}

DEV void mlstm_gates(const Params& p, int l, int h, size_t row, float& b, float& a) {
    const float* gf = (const float*)(p.ws + WS_GF) + row * 8;
    const float gi = gf[h] + p.in[18][l * 4 + h];
    const float fx = gf[4 + h] + p.in[19][l * 4 + h];
    const float lf = fminf(fx, 0.f) - log1p_fast(fexp(-fabsf(fx)));
    float s = lf;
#pragma unroll
    for (int d = 1; d < 64; d <<= 1) { const float o = shfl_up(s, d); if ((tid() & 63) >= d) s += o; }
    b = s; a = gi - s;
}
constexpr int MP = 72;
DEV void mlstm_local_unit(const Params& p, int l, int u) {
    const int t = tid(), lane = t & 63, w = t >> 6, r32 = lane & 31, hi = lane >> 5, h = w >> 1, half = w & 1;
    unsigned char* lds = lds_base();
    unsigned short* Kt = (unsigned short*)(lds + h * (2 * 64 * MP * 2));
    unsigned short* Vt = Kt + 64 * MP;
    const unsigned short* Z = (const unsigned short*)(p.ws + WS_HZ);
    const size_t row = (size_t)u * 64 + lane;
    float b, a; mlstm_gates(p, l, h, row, b, a);
    const float A = wave_max(a), g = shfl_idx(b, 63);
    const float wgt = ex2((a - A) * LOG2E) * 0.125f;
    {
        const unsigned short* src = Z + row * NINP + (half ? ZC_MV : ZC_MK) + 64 * h;
        unsigned short* dstT = half ? Vt : Kt; const float sc = half ? 1.0f : wgt;
#pragma unroll
        for (int c = 0; c < 8; ++c) { const bf16x8 x = *(const bf16x8*)(src + 8 * c);
#pragma unroll
            for (int j = 0; j < 8; ++j) dstT[(8 * c + j) * MP + lane] = half ? (unsigned short)x[j] : f2bf(bfs2f(x[j]) * sc); }
    }
    bsync();
    const int b_ = u / NC, c_ = u % NC; const size_t bhc = ((size_t)(b_ * 4 + h) * NC + c_);
    {
        f32x16 acc[2] = {{}, {}};
#pragma unroll
        for (int ks = 0; ks < 4; ++ks) {
            const bf16x8 af = *(const bf16x8*)(Kt + (32 * half + r32) * MP + 16 * ks + 8 * hi);
#pragma unroll
            for (int fb = 0; fb < 2; ++fb) acc[fb] = mfma32(af, *(const bf16x8*)(Vt + (32 * fb + r32) * MP + 16 * ks + 8 * hi), acc[fb]);
        }
        float* CT = (float*)(p.ws + WS_CT) + bhc * 4096;
#pragma unroll
        for (int fb = 0; fb < 2; ++fb)
#pragma unroll
            for (int gq = 0; gq < 4; ++gq) { f32x4 o = {acc[fb][4 * gq], acc[fb][4 * gq + 1], acc[fb][4 * gq + 2], acc[fb][4 * gq + 3]}; *(f32x4*)(CT + (32 * fb + r32) * 64 + 32 * half + 8 * gq + 4 * hi) = o; }
    }
    if (half == 0) { float s = 0.f;
#pragma unroll 8
        for (int q = 0; q < 64; ++q) s += bf2f(Kt[lane * MP + q]);
        ((float*)(p.ws + WS_NU))[bhc * 64 + lane] = s; }
    else if (lane == 0) { float* ag = (float*)(p.ws + WS_AG) + bhc * 2; ag[0] = A; ag[1] = g; }
    bsync();
}

DEV void phase_m1(const Params& p, int l) {
    if (UM(0)) for (int u = bid(); u < M / 64; u += nblk()) mla_prep_unit(p, l, u);
    if (UM(1)) for (int u = bid(); u < M / 64; u += nblk()) mlstm_local_unit(p, l, u);
    if (UM(2)) for (int u = bid(); u < M / 32; u += nblk()) lru_unit<0>(p, l, u);
}

DEV void phase_m1b(const Params& p) {
    const int gt = bid() * 512 + tid(), NT_ = nblk() * 512;
    const float* AG = (const float*)(p.ws + WS_AG);
    for (int idx = gt; idx < NB * 4 * (4096 + 64); idx += NT_) {
        const bool isn = idx >= NB * 4 * 4096;
        const int q = isn ? idx - NB * 4 * 4096 : idx, per = isn ? 64 : 4096;
        const int bh = q / per, el = q % per;
        float* base = (isn ? (float*)(p.ws + WS_NU) : (float*)(p.ws + WS_CT)) + (size_t)bh * NC * per + el;
        float uv[NC];
#pragma unroll
        for (int c = 0; c < NC; ++c) uv[c] = base[(size_t)c * per];
        float m = 0.f, C = 0.f;
#pragma unroll
        for (int c = 0; c < NC; ++c) {
            const float A = AG[(bh * NC + c) * 2], g = AG[(bh * NC + c) * 2 + 1];
            const float Mx = fmaxf(m, A);
            base[(size_t)c * per] = C;
            if (isn && el == 0) ((float*)(p.ws + WS_MS))[bh * NC + c] = m;
            C = fexp(m - Mx) * C + fexp(A - Mx) * uv[c];
            m = g + Mx;
        }
    }
    const float* LAC = (const float*)(p.ws + WS_LAC); const float* LHC = (const float*)(p.ws + WS_LHC); float* LCR = (float*)(p.ws + WS_LCR);
    for (int idx = gt; idx < NB * 256; idx += NT_) {
        const int b = idx / 256, ch = idx % 256; float carry = 0.f;
        for (int c = 0; c < NLC; ++c) { const size_t o = ((size_t)(b * NLC + c)) * 256 + ch; LCR[o] = carry; carry = LAC[o] * carry + LHC[o]; }
    }
}

constexpr float NEGBIG = -1e30f;
DEV float dil_madd(int rel) {
    const int mult = (rel <= 128 ? 1 : 0) + ((((rel & 3) == 0) && rel <= 512) ? 1 : 0) + ((((rel & 15) == 0) && rel <= 2048) ? 1 : 0);
    const float v = (mult == 1) ? 0.f : ((mult == 2) ? 1.0f : 1.5849625007211562f);
    return (rel < 0 || mult == 0) ? NEGBIG : v;
}
DEV void group_norm_store(const Params& p, int l, f32x16 (&o)[2], float* red, int gcol, int h, int rh, int r32, int hi, size_t grow) {
    float ss = 0.f;
#pragma unroll
    for (int blk = 0; blk < 2; ++blk)
#pragma unroll
        for (int reg = 0; reg < 16; ++reg) ss += o[blk][reg] * o[blk][reg];
    ss += shfl_xor(ss, 32);
    if (hi == 0) red[(32 * rh + r32) * 4 + h] = ss;
    bsync();
    const float tot = (red[(32 * rh + r32) * 4 + 0] + red[(32 * rh + r32) * 4 + 1]) + (red[(32 * rh + r32) * 4 + 2] + red[(32 * rh + r32) * 4 + 3]);
    const float rstd = 1.0f / sqrtf(tot * (1.f / 256.f) + 1e-6f);
    const float* on = p.in[20] + (size_t)l * D + gcol + 64 * h;
    unsigned short* dst = (unsigned short*)(p.ws + WS_XB) + grow * D + gcol + 64 * h;
#pragma unroll
    for (int blk = 0; blk < 2; ++blk)
#pragma unroll
        for (int g = 0; g < 4; ++g) { const int d0 = 32 * blk + 8 * g + 4 * hi; const f32x4 w4 = *(const f32x4*)(on + d0);
            u32x2 ov; ov.x = pk2(o[blk][4 * g] * rstd * w4.x, o[blk][4 * g + 1] * rstd * w4.y); ov.y = pk2(o[blk][4 * g + 2] * rstd * w4.z, o[blk][4 * g + 3] * rstd * w4.w);
            *(u32x2*)(dst + d0) = ov; }
    bsync();
}

template <int EQK, int MODE> DEV void attn_qk(const unsigned short* Ks, const bf16x8 (&qf)[EQK / 16], f32x16 (&o)[2], bf16x8 (&pf)[4], float& m_run, float& l_run,
                                              const float sc, const int qpos, const int kv0, const int r32, const int hi, const float (&sm)[16]) {
    constexpr int KP = EQK + 8;
    f32x16 p0 = {}, p1 = {};
#pragma unroll
    for (int ks = 0; ks < EQK / 16; ++ks) {
        p0 = mfma32(*(const bf16x8*)(Ks + r32 * KP + 16 * ks + 8 * hi), qf[ks], p0);
        p1 = mfma32(*(const bf16x8*)(Ks + (32 + r32) * KP + 16 * ks + 8 * hi), qf[ks], p1);
    }
    float mx = NEGBIG, m_new;
    if (MODE == 0) {
#pragma unroll
        for (int reg = 0; reg < 16; ++reg) mx = fmaxf(mx, fmaxf(p0[reg], p1[reg]));
        mx = fmaxf(mx, shfl_xor(mx, 32));
        m_new = fmaxf(m_run, mx * sc);
#pragma unroll
        for (int reg = 0; reg < 16; ++reg) { p0[reg] = ex2(p0[reg] * sc - m_new); p1[reg] = ex2(p1[reg] * sc - m_new); }
    } else {
#pragma unroll
        for (int reg = 0; reg < 16; ++reg) {
            const int rel = qpos - (kv0 + crow(reg, hi));
            float a0, a1;
            if (MODE == 1) { a0 = rel < 0 ? NEGBIG : 0.f; a1 = rel - 32 < 0 ? NEGBIG : 0.f; }
            else if (MODE == 2) { a0 = dil_madd(rel); a1 = dil_madd(rel - 32); }
            else { a0 = sm[reg]; a1 = sm[reg]; }
            p0[reg] = p0[reg] * sc + a0; p1[reg] = p1[reg] * sc + a1; mx = fmaxf(mx, fmaxf(p0[reg], p1[reg]));
        }
        mx = fmaxf(mx, shfl_xor(mx, 32));
        m_new = fmaxf(m_run, mx);
#pragma unroll
        for (int reg = 0; reg < 16; ++reg) { p0[reg] = ex2(p0[reg] - m_new); p1[reg] = ex2(p1[reg] - m_new); }
    }
    const float alpha = ex2(m_run - m_new); m_run = m_new;
    float ls = 0.f;
#pragma unroll
    for (int reg = 0; reg < 16; ++reg) ls += p0[reg] + p1[reg];
    l_run = l_run * alpha + ls;
    o[0] = o[0] * alpha; o[1] = o[1] * alpha;
    pf[0] = pack8(p0[0], p0[1], p0[2], p0[3], p0[4], p0[5], p0[6], p0[7]); pf[1] = pack8(p0[8], p0[9], p0[10], p0[11], p0[12], p0[13], p0[14], p0[15]);
    pf[2] = pack8(p1[0], p1[1], p1[2], p1[3], p1[4], p1[5], p1[6], p1[7]); pf[3] = pack8(p1[8], p1[9], p1[10], p1[11], p1[12], p1[13], p1[14], p1[15]);
}
DEV void attn_pv(const unsigned short* Vt, const bf16x8 (&pf)[4], f32x16 (&o)[2], const int r32, const int hi) {
#pragma unroll
    for (int s = 0; s < 4; ++s)
#pragma unroll
        for (int blk = 0; blk < 2; ++blk) {
            const unsigned short* vp = Vt + (32 * blk + r32) * MP + 16 * s + 4 * hi;
            const bf16x4 lo = *(const bf16x4*)vp, hh = *(const bf16x4*)(vp + 8);
            const bf16x8 af = {lo[0], lo[1], lo[2], lo[3], hh[0], hh[1], hh[2], hh[3]};
            o[blk] = mfma32(af, pf[s], o[blk]);
        }
}
template <int EQK, bool DIL> DEV void attn_unit(const Params& p, int l, int b, int qb) {
    const int t = tid(), lane = t & 63, w = t >> 6, h = w >> 1, rh = w & 1, r32 = lane & 31, hi = lane >> 5;
    constexpr int KP = EQK + 8, KBYTES = 64 * KP * 2, VBYTES = 64 * MP * 2, HB = KBYTES + VBYTES;
    constexpr int NKC = EQK / 16;
    unsigned char* lds = lds_base();
    const unsigned short* Ks = (const unsigned short*)(lds + h * HB);
    const unsigned short* Vt = (const unsigned short*)(lds + h * HB + KBYTES);
    float* red = (float*)(lds + 4 * HB);
    const unsigned short* Z = (const unsigned short*)(p.ws + WS_HZ);
    const unsigned short *Qg, *Kg, *Vg; int pq, pk, pv; float sc;
    if (DIL) { Qg = Z + ZC_SQ; Kg = Z + ZC_SK; Vg = Z + ZC_SV; pq = pk = pv = NINP; sc = 0.125f * LOG2E; }
    else { Qg = (const unsigned short*)(p.ws + WS_QM); Kg = (const unsigned short*)(p.ws + WS_KM); Vg = (const unsigned short*)(p.ws + WS_VM); pq = pk = 384; pv = 256; sc = 0.10206207261596577f * LOG2E; }
    const size_t row0 = (size_t)b * SEQ; const int q0 = qb * 64, qpos = q0 + 32 * rh + r32;
    bf16x8 qf[EQK / 16];
#pragma unroll
    for (int ks = 0; ks < EQK / 16; ++ks) qf[ks] = *(const bf16x8*)(Qg + (row0 + qpos) * pq + h * EQK + 16 * ks + 8 * hi);
    float sm[16];
#pragma unroll
    for (int reg = 0; reg < 16; ++reg) sm[reg] = (DIL && (((qpos - crow(reg, hi)) & 15) == 0)) ? 0.f : NEGBIG;
    const int nt = qb + 1;
    bf16x8 kreg[NKC], vreg[4];
    auto prefetchK = [&](int kv0) {
#pragma unroll
        for (int i = 0; i < NKC; ++i) { const int tok = t >> 3, c = (t & 7) + 8 * i; kreg[i] = *(const bf16x8*)(Kg + (row0 + kv0 + tok) * pk + c * 8); }
    };
    auto prefetchV = [&](int kv0) {
#pragma unroll
        for (int i = 0; i < 4; ++i) { const int c = w + 8 * i; vreg[i] = *(const bf16x8*)(Vg + (row0 + kv0 + lane) * pv + c * 8); }
    };
    auto stage = [&]() {
#pragma unroll
        for (int i = 0; i < NKC; ++i) { const int tok = t >> 3, c = (t & 7) + 8 * i, hd = c / (EQK / 8), wi = c % (EQK / 8);
            *(bf16x8*)(lds + hd * HB + (tok * KP + wi * 8) * 2) = kreg[i]; }
#pragma unroll
        for (int i = 0; i < 4; ++i) { const int c = w + 8 * i, hd = c >> 3, dc = c & 7; unsigned short* vt = (unsigned short*)(lds + hd * HB + KBYTES);
#pragma unroll
            for (int j = 0; j < 8; ++j) vt[(8 * dc + j) * MP + lane] = (unsigned short)vreg[i][j]; }
    };
    f32x16 o[2] = {{}, {}};
    float m_run = NEGBIG, l_run = 0.f;
    prefetchK(0); prefetchV(0);
    const int nfar = DIL ? (qb - 8 > 0 ? qb - 8 : 0) : nt - 1;
    for (int tt = 0; tt < nt; ++tt) {
        const int kv0 = tt * 64;
        bsync();
        stage();
        if (tt + 1 < nt) prefetchK(kv0 + 64);
        bsync();
        bf16x8 pf[4];
        if (tt < nfar) attn_qk<EQK, DIL ? 3 : 0>(Ks, qf, o, pf, m_run, l_run, sc, qpos, kv0, r32, hi, sm);
        else attn_qk<EQK, DIL ? 2 : 1>(Ks, qf, o, pf, m_run, l_run, sc, qpos, kv0, r32, hi, sm);
        if (tt + 1 < nt) prefetchV(kv0 + 64);
        attn_pv(Vt, pf, o, r32, hi);
    }
    l_run += shfl_xor(l_run, 32);
    const float inv = 1.0f / l_run;
    o[0] = o[0] * inv; o[1] = o[1] * inv;
    bsync();
    group_norm_store(p, l, o, red, DIL ? 512 : 0, h, rh, r32, hi, row0 + qpos);
}

DEV void mlstm_out_unit(const Params& p, int l, int u) {
    const int t = tid(), lane = t & 63, w = t >> 6, r32 = lane & 31, hi = lane >> 5, h = w >> 1, half = w & 1;
    constexpr int HB = 3 * 64 * MP * 2 + 512;
    unsigned char* lds = lds_base();
    unsigned short* Ks = (unsigned short*)(lds + h * HB);
    unsigned short* Vt = Ks + 64 * MP;
    unsigned short* Cb = Vt + 64 * MP;
    float* nv = (float*)(lds + h * HB + 3 * 64 * MP * 2);
    float* av = nv + 64;
    float* red = (float*)(lds + 4 * HB);
    const unsigned short* Z = (const unsigned short*)(p.ws + WS_HZ);
    const int b_ = u / NC, c_ = u % NC; const size_t bhc = ((size_t)(b_ * 4 + h) * NC + c_);
    const size_t row = (size_t)u * 64 + lane;
    float b, a; mlstm_gates(p, l, h, row, b, a);
    float cm = a;
#pragma unroll
    for (int d = 1; d < 64; d <<= 1) { const float ov = shfl_up(cm, d); if (lane >= d) cm = fmaxf(cm, ov); }
    const float mprev = ((const float*)(p.ws + WS_MS))[bhc];
    const float Mt_l = fmaxf(cm, mprev);
    const int tq = 32 * half + r32;
    const float Mt = shfl_idx(Mt_l, tq), bt = shfl_idx(b, tq);
    const float winter = ex2((mprev - Mt) * LOG2E), emt = ex2(-(bt + Mt) * LOG2E);
    av[lane] = a;
    {
        const unsigned short* src = Z + row * NINP + (half ? ZC_MV : ZC_MK) + 64 * h;
#pragma unroll
        for (int c = 0; c < 8; ++c) { const bf16x8 x = *(const bf16x8*)(src + 8 * c);
            if (half) {
#pragma unroll
                for (int j = 0; j < 8; ++j) Vt[(8 * c + j) * MP + lane] = (unsigned short)x[j];
            } else *(bf16x8*)(Ks + lane * MP + 8 * c) = x; }
        const int q = half * 64 + lane, f = q >> 1, e0 = (q & 1) * 32;
        const float* csrc = (const float*)(p.ws + WS_CT) + bhc * 4096 + f * 64 + e0;
#pragma unroll
        for (int i = 0; i < 4; ++i) { const f32x4 x0 = *(const f32x4*)(csrc + 8 * i), x1 = *(const f32x4*)(csrc + 8 * i + 4);
            *(bf16x8*)(Cb + f * MP + e0 + 8 * i) = pack8(x0.x, x0.y, x0.z, x0.w, x1.x, x1.y, x1.z, x1.w); }
        if (half == 0) nv[lane] = ((const float*)(p.ws + WS_NU))[bhc * 64 + lane];
    }
    bsync();
    const size_t grow = (size_t)u * 64 + tq;
    bf16x8 qf[4];
#pragma unroll
    for (int ks = 0; ks < 4; ++ks) qf[ks] = *(const bf16x8*)(Z + grow * NINP + ZC_MQ + 64 * h + 16 * ks + 8 * hi);
    f32x16 p0 = {}, p1 = {};
#pragma unroll
    for (int ks = 0; ks < 4; ++ks) {
        p0 = mfma32(*(const bf16x8*)(Ks + r32 * MP + 16 * ks + 8 * hi), qf[ks], p0);
        p1 = mfma32(*(const bf16x8*)(Ks + (32 + r32) * MP + 16 * ks + 8 * hi), qf[ks], p1);
    }
    float dsum = 0.f;
#pragma unroll
    for (int reg = 0; reg < 16; ++reg) {
        const int s0 = crow(reg, hi), s1 = 32 + s0;
        const float c0 = (s0 <= tq) ? ex2((av[s0] - Mt) * LOG2E) * 0.125f : 0.f, c1 = (s1 <= tq) ? ex2((av[s1] - Mt) * LOG2E) * 0.125f : 0.f;
        p0[reg] *= c0; p1[reg] *= c1; dsum += p0[reg] + p1[reg];
    }
    dsum += shfl_xor(dsum, 32);
    bf16x8 pf[4];
    pf[0] = pack8(p0[0], p0[1], p0[2], p0[3], p0[4], p0[5], p0[6], p0[7]); pf[1] = pack8(p0[8], p0[9], p0[10], p0[11], p0[12], p0[13], p0[14], p0[15]);
    pf[2] = pack8(p1[0], p1[1], p1[2], p1[3], p1[4], p1[5], p1[6], p1[7]); pf[3] = pack8(p1[8], p1[9], p1[10], p1[11], p1[12], p1[13], p1[14], p1[15]);
    f32x16 o[2] = {{}, {}};
    float qn = 0.f;
#pragma unroll
    for (int ks = 0; ks < 4; ++ks) {
#pragma unroll
        for (int fb = 0; fb < 2; ++fb) o[fb] = mfma32(*(const bf16x8*)(Cb + (32 * fb + r32) * MP + 16 * ks + 8 * hi), qf[ks], o[fb]);
#pragma unroll
        for (int j = 0; j < 8; ++j) qn += bfs2f(qf[ks][j]) * nv[16 * ks + 8 * hi + j];
    }
    qn += shfl_xor(qn, 32);
    o[0] = o[0] * winter; o[1] = o[1] * winter;
#pragma unroll
    for (int s = 0; s < 4; ++s)
#pragma unroll
        for (int fb = 0; fb < 2; ++fb) {
            const unsigned short* vp = Vt + (32 * fb + r32) * MP + 16 * s + 4 * hi;
            const bf16x4 lo = *(const bf16x4*)vp, hh = *(const bf16x4*)(vp + 8);
            const bf16x8 af = {lo[0], lo[1], lo[2], lo[3], hh[0], hh[1], hh[2], hh[3]};
            o[fb] = mfma32(af, pf[s], o[fb]);
        }
    const float den = dsum + winter * qn;
    const float inv = 1.0f / fmaxf(fabsf(den), emt);
    const unsigned short* og = Z + grow * NINP + ZC_MO + 64 * h;
#pragma unroll
    for (int fb = 0; fb < 2; ++fb)
#pragma unroll
        for (int g = 0; g < 4; ++g) { const bf16x4 gv = *(const bf16x4*)(og + 32 * fb + 8 * g + 4 * hi);
#pragma unroll
            for (int i = 0; i < 4; ++i) o[fb][4 * g + i] = o[fb][4 * g + i] * inv * sigmoidf_(bfs2f(gv[i])); }
    group_norm_store(p, l, o, red, 768, h, half, r32, hi, grow);
}

DEV void phase_m2(const Params& p, int l) {
    if (UM(3)) for (int u = bid(); u < NB * NQ; u += nblk()) attn_unit<96, false>(p, l, u / NQ, u % NQ);
    if (UM(4)) for (int u = bid(); u < NB * NQ; u += nblk()) attn_unit<64, true>(p, l, u / NQ, NQ - 1 - (u % NQ));
    if (UM(5)) for (int u = bid(); u < M / 64; u += nblk()) mlstm_out_unit(p, l, u);
    if (UM(6)) for (int u = bid(); u < M / 32; u += nblk()) lru_unit<1>(p, l, u);
}

#ifdef EMU
DEV float emu_dot(const unsigned short* a, const unsigned short* b, int K) { double s = 0; for (int k = 0; k < K; ++k) s += (double)bf2f(a[k]) * bf2f(b[k]); return (float)s; }
DEV void emu_gemm_up(const Params& p, int l, int f) {
    if (bid() != 0 || tid() != 0) return;
    const unsigned short* A = (const unsigned short*)(p.ws + WS_XB); const unsigned short* Bt = W13T(p, l, f); unsigned short* H = (unsigned short*)(p.ws + WS_HZ);
    for (int r = 0; r < M; ++r) for (int j = 0; j < DFF; ++j) { const int pn = j / 128, jj = j % 128;
        const float a = emu_dot(A + (size_t)r * D, Bt + (size_t)(256 * pn + jj) * D, D), g = emu_dot(A + (size_t)r * D, Bt + (size_t)(256 * pn + 128 + jj) * D, D);
        H[(size_t)r * DFF + j] = f2bf(a / (1.0f + expf(-a)) * g); }
}
DEV void emu_gemm_resid(const Params& p, const unsigned short* A, const unsigned short* Bt, int K, const float* base, float alpha, float coef) {
    if (bid() != 0 || tid() != 0) return;
    for (int r = 0; r < M; ++r) for (int c = 0; c < D; ++c) p.out[(size_t)r * D + c] = alpha * base[(size_t)r * D + c] + coef * emu_dot(A + (size_t)r * K, Bt + (size_t)c * K, K);
}
DEV void emu_gemm_z(const Params& p, int l) {
    if (bid() != 0 || tid() != 0) return;
    const unsigned short* A = (const unsigned short*)(p.ws + WS_XB); const unsigned short* Bt = WINT(p, l); unsigned short* Zb = (unsigned short*)(p.ws + WS_HZ); float* GF = (float*)(p.ws + WS_GF);
    for (int r = 0; r < M; ++r) for (int c = 0; c < NINP; ++c) { const float v = emu_dot(A + (size_t)r * D, Bt + (size_t)c * D, D); Zb[(size_t)r * NINP + c] = f2bf(v); if (c >= ZC_MI && c < ZC_MI + 8) GF[(size_t)r * 8 + c - ZC_MI] = v; }
}
#else
namespace pg8 {
#define PG8_LAS __attribute__((address_space(3)))
typedef unsigned short bf16_t;
constexpr int BM = 256, BK = 64, HALF = 128, HTB = HALF * BK * 2, STAGE_BYTES = 8 * HTB, NXCD = 8, WGM = 8;
__host__ __device__ __forceinline__ int lds_byte(int r, int c) { const int st = (r >> 4) * 2 + (c >> 5), rr = r & 15, cc = c & 31, ob = rr * 64 + cc * 2; return st * 1024 + (ob ^ (((ob >> 9) & 1) << 5)); }
__host__ __device__ __forceinline__ void stage_rc(int b, int& R, int& C) { const int st = b / 1024, sb = b % 1024, swz = sb ^ (((sb >> 9) & 1) << 5); R = (st >> 1) * 16 + swz / 64; C = (st & 1) * 32 + (swz % 64) / 2; }
__host__ __device__ __forceinline__ int perm32(int rho) { const int n = rho >> 4, i = rho & 15; return 8 * (i >> 2) + 4 * n + (i & 3); }
struct Unit { int pm, pn; };
struct Gemm { const bf16_t* A; const bf16_t* Bt; int M, N, K; };
struct StaticOrder {
    int nM, nN, nwg, G, c;
    __host__ __device__ void init(int M_, int N_, int G_, int c_) { nM = M_ / BM; nN = N_ / BM; nwg = nM * nN; G = G_; c = c_; }
    __host__ __device__ bool next(int i, Unit& u) const {
        const long L = (long)i * G + c; if (L >= nwg) return false;
        int wgid = (int)L; { const int q = nwg / NXCD, r = nwg % NXCD, xcd = wgid % NXCD, off = wgid / NXCD; wgid = (xcd < r ? xcd * (q + 1) : r * (q + 1) + (xcd - r) * q) + off; }
        const int nig = WGM * nN, gid = wgid / nig, fm = gid * WGM, gsz = (nM - fm) < WGM ? (nM - fm) : WGM;
        u.pm = fm + ((wgid % nig) % gsz); u.pn = (wgid % nig) / gsz; return true;
    }
    __device__ __forceinline__ void a_ready(const Unit&) const {}
    __device__ __forceinline__ void done(const Unit&) const {}
};
struct EpiSwiGLU {
    static constexpr bool PERM = true, AFTER_DRAIN = false;
    bf16_t* H;
    __device__ __forceinline__ void operator()(const f32x4 (&acc)[2][2][4][2], const Unit& u, int wr, int wc, int fr, int fq) const {
        const int row0 = u.pm * BM + wr * 64 + fr, col0 = u.pn * HALF + wc * 32 + 8 * fq;
#pragma unroll
        for (int ai = 0; ai < 2; ++ai)
#pragma unroll
            for (int m = 0; m < 4; ++m) {
                float hv[8];
#pragma unroll
                for (int n = 0; n < 2; ++n)
#pragma unroll
                    for (int i = 0; i < 4; ++i) { const float a = acc[ai][0][m][n][i], g = acc[ai][1][m][n][i]; hv[4 * n + i] = a * sigmoidf_(a) * g; }
                *(bf16x8*)(H + (size_t)(row0 + ai * HALF + m * 16) * DFF + col0) = pack8(hv[0], hv[1], hv[2], hv[3], hv[4], hv[5], hv[6], hv[7]);
            }
    }
};
struct EpiResid {
    static constexpr bool PERM = false, AFTER_DRAIN = false;
    const float* base; float* out; float alpha, coef;
    __device__ __forceinline__ void operator()(const f32x4 (&acc)[2][2][4][2], const Unit& u, int wr, int wc, int fr, int fq) const {
        const int row0 = u.pm * BM + wr * 64 + fr, col0 = u.pn * BM + wc * 32 + 4 * fq;
#pragma unroll
        for (int ai = 0; ai < 2; ++ai)
#pragma unroll
            for (int m = 0; m < 4; ++m) { const size_t off = (size_t)(row0 + ai * HALF + m * 16) * D + col0;
#pragma unroll
                for (int bj = 0; bj < 2; ++bj)
#pragma unroll
                    for (int n = 0; n < 2; ++n) { const f32x4 bs = *(const f32x4*)(base + off + bj * HALF + n * 16); *(f32x4*)(out + off + bj * HALF + n * 16) = bs * alpha + acc[ai][bj][m][n] * coef; } }
    }
};
struct EpiZ {
    static constexpr bool PERM = true, AFTER_DRAIN = false;
    bf16_t* Zb; float* GF;
    __device__ __forceinline__ void operator()(const f32x4 (&acc)[2][2][4][2], const Unit& u, int wr, int wc, int fr, int fq) const {
        const int row0 = u.pm * BM + wr * 64 + fr, col0 = u.pn * BM + wc * 32 + 8 * fq;
#pragma unroll
        for (int ai = 0; ai < 2; ++ai)
#pragma unroll
            for (int m = 0; m < 4; ++m) { const size_t r = (size_t)(row0 + ai * HALF + m * 16);
#pragma unroll
                for (int bj = 0; bj < 2; ++bj) { const f32x4 v0 = acc[ai][bj][m][0], v1 = acc[ai][bj][m][1];
                    *(bf16x8*)(Zb + r * NINP + col0 + bj * HALF) = pack8(v0[0], v0[1], v0[2], v0[3], v1[0], v1[1], v1[2], v1[3]);
                    if (col0 + bj * HALF == ZC_MI) { *(f32x4*)(GF + r * 8) = v0; *(f32x4*)(GF + r * 8 + 4) = v1; } } }
    }
};

template <class Epi, class Sched, bool ALIGN_EPI = false, bool SP2 = false>
__device__ __forceinline__ void gemm_phase(PG8_LAS unsigned char* lds, const Gemm g, const Sched& S, const Epi& E) {
    const int tid = ::tid(), wid = __builtin_amdgcn_readfirstlane(tid >> 6), lane = tid & 63, wr = wid >> 2, wc = wid & 3, fr = lane & 15, fq = lane >> 4;
    const int K = g.K, nt = K / BK;
    unsigned voffA[2], voffB[2];
#pragma unroll
    for (int i = 0; i < 2; ++i) { int R, C; stage_rc(tid * 16 + i * 8192, R, C); const int Rb = Epi::PERM ? ((R & ~31) + perm32(R & 31)) : R;
        voffA[i] = (unsigned)(R * K + C) * 2u; voffB[i] = (unsigned)(Rb * K + C) * 2u; }
    const size_t kstep = (size_t)(BK * 2);
    const size_t hstep = (size_t)HALF * K * 2;
    const size_t tstep = 2 * hstep;
    const unsigned ldsw = (unsigned)wid * 1024u;
    const int aoff = lds_byte(wr * 64 + fr, fq * 8), boff = lds_byte(wc * 32 + fr, fq * 8);
#define PG8_SA(b, h) (((b) * 2 + (h)) * HTB)
#define PG8_SB(b, h) ((4 + (b) * 2 + (h)) * HTB)
#define PG8_STAGE(bufoff, gbase, voff) do { _Pragma("unroll") for (int _i = 0; _i < 2; ++_i) \
        __builtin_amdgcn_global_load_lds((const unsigned*)((const char*)(gbase) + (voff)[_i]), (PG8_LAS unsigned*)(lds + (bufoff) + ldsw + _i * 8192), 16, 0, 0); } while (0)
#define PG8_LDA(dst, b, h) do { _Pragma("unroll") for (int m = 0; m < 4; ++m) _Pragma("unroll") for (int k = 0; k < 2; ++k) dst[m][k] = *(const PG8_LAS bf16x8*)(lds + PG8_SA(b, h) + aoff + m * 2048 + k * 1024); } while (0)
#define PG8_LDB(dst, b, h) do { _Pragma("unroll") for (int n = 0; n < 2; ++n) _Pragma("unroll") for (int k = 0; k < 2; ++k) dst[n][k] = *(const PG8_LAS bf16x8*)(lds + PG8_SB(b, h) + boff + n * 2048 + k * 1024); } while (0)
#define PG8_MMA(ai, bj, At, Bt) do { __builtin_amdgcn_s_setprio(1); _Pragma("unroll") for (int m = 0; m < 4; ++m) _Pragma("unroll") for (int n = 0; n < 2; ++n) _Pragma("unroll") for (int k = 0; k < 2; ++k) \
        acc[ai][bj][m][n] = __builtin_amdgcn_mfma_f32_16x16x32_bf16(Bt[n][k], At[m][k], acc[ai][bj][m][n], 0, 0, 0); __builtin_amdgcn_s_setprio(0); } while (0)
#define PG8_WAIT_V(n) asm volatile("s_waitcnt vmcnt(" #n ")" ::: "memory")
#define PG8_WAIT_L(n) asm volatile("s_waitcnt lgkmcnt(" #n ")" ::: "memory")
#define PG8_BAR __builtin_amdgcn_s_barrier()
#define PG8_SCHED __builtin_amdgcn_sched_barrier(0)
    Unit cur, nxt; int ui = 0;
    if (!S.next(0, cur)) return;
    f32x4 acc[2][2][4][2];
#pragma unroll
    for (int a = 0; a < 2; ++a)
#pragma unroll
        for (int b = 0; b < 2; ++b)
#pragma unroll
            for (int m = 0; m < 4; ++m)
#pragma unroll
                for (int n = 0; n < 2; ++n) acc[a][b][m][n] = (f32x4){0.f, 0.f, 0.f, 0.f};
    bf16x8 At[4][2], B0[2][2], B1[2][2];
    const char* cA = (const char*)g.A + (size_t)cur.pm * tstep; const char* cB = (const char*)g.Bt + (size_t)cur.pn * tstep;
    S.a_ready(cur);
    if constexpr (SP2) {
        PG8_STAGE(PG8_SB(0, 0), cB, voffB); PG8_STAGE(PG8_SB(0, 1), cB + hstep, voffB); PG8_STAGE(PG8_SA(0, 0), cA, voffA); PG8_STAGE(PG8_SA(0, 1), cA + hstep, voffA);
        if (wr == 1) PG8_BAR;
        PG8_WAIT_V(2); PG8_BAR;
        PG8_STAGE(PG8_SB(1, 0), cB + kstep, voffB); PG8_STAGE(PG8_SA(1, 0), cA + kstep, voffA); PG8_STAGE(PG8_SB(1, 1), cB + hstep + kstep, voffB);
        PG8_WAIT_V(6); PG8_BAR;
    } else {
        PG8_STAGE(PG8_SB(0, 0), cB, voffB); PG8_STAGE(PG8_SA(0, 0), cA, voffA); PG8_STAGE(PG8_SB(0, 1), cB + hstep, voffB); PG8_STAGE(PG8_SA(0, 1), cA + hstep, voffA);
        if (wr == 1) PG8_BAR;
        PG8_WAIT_V(4); PG8_BAR;
        PG8_STAGE(PG8_SB(1, 0), cB + kstep, voffB); PG8_STAGE(PG8_SA(1, 0), cA + kstep, voffA); PG8_STAGE(PG8_SB(1, 1), cB + hstep + kstep, voffB);
        PG8_WAIT_V(6); PG8_BAR;
    }
    for (;;) {
        const bool has_next = S.next(ui + 1, nxt);
        const char* nA = has_next ? (const char*)g.A + (size_t)nxt.pm * tstep : cA; const char* nB = has_next ? (const char*)g.Bt + (size_t)nxt.pn * tstep : cB;
        for (int t = 0; t < nt; t += 2) {
            const bool last = (t == nt - 2);
            const char* a1 = cA + (size_t)(t + 1) * kstep;
            const char* a2 = last ? nA : cA + (size_t)(t + 2) * kstep; const char* b2 = last ? nB : cB + (size_t)(t + 2) * kstep;
            const char* a3 = a2 + kstep; const char* b3 = b2 + kstep;
            if (last && has_next) S.a_ready(nxt);
            if constexpr (SP2) {
            PG8_LDB(B0, 0, 0); PG8_LDB(B1, 0, 1); PG8_SCHED; PG8_LDA(At, 0, 0); PG8_STAGE(PG8_SA(1, 1), a1 + hstep, voffA);
            PG8_WAIT_V(8); PG8_WAIT_L(0); PG8_BAR; PG8_MMA(0, 0, At, B0); PG8_MMA(0, 1, At, B1); PG8_BAR; PG8_SCHED;
            PG8_LDA(At, 0, 1); PG8_STAGE(PG8_SB(0, 0), b2, voffB); PG8_STAGE(PG8_SB(0, 1), b2 + hstep, voffB); PG8_STAGE(PG8_SA(0, 0), a2, voffA);
            PG8_WAIT_V(8); PG8_WAIT_L(0); PG8_BAR; PG8_MMA(1, 0, At, B0); PG8_MMA(1, 1, At, B1); PG8_BAR; PG8_SCHED;
            PG8_LDB(B0, 1, 0); PG8_LDB(B1, 1, 1); PG8_SCHED; PG8_LDA(At, 1, 0); PG8_STAGE(PG8_SA(0, 1), a2 + hstep, voffA);
            PG8_WAIT_V(8); PG8_WAIT_L(0); PG8_BAR; PG8_MMA(0, 0, At, B0); PG8_MMA(0, 1, At, B1); PG8_BAR; PG8_SCHED;
            PG8_LDA(At, 1, 1); PG8_STAGE(PG8_SB(1, 0), b3, voffB); PG8_STAGE(PG8_SB(1, 1), b3 + hstep, voffB); PG8_STAGE(PG8_SA(1, 0), a3, voffA);
            PG8_WAIT_V(8); PG8_WAIT_L(0); PG8_BAR; PG8_MMA(1, 0, At, B0); PG8_MMA(1, 1, At, B1); PG8_BAR; PG8_SCHED;
            } else {
            PG8_LDB(B0, 0, 0); PG8_SCHED; PG8_LDA(At, 0, 0); PG8_STAGE(PG8_SA(1, 1), a1 + hstep, voffA);
            PG8_WAIT_L(8); PG8_BAR; PG8_WAIT_L(0); PG8_MMA(0, 0, At, B0); PG8_BAR; PG8_SCHED;
            PG8_LDB(B1, 0, 1); PG8_STAGE(PG8_SB(0, 0), b2, voffB);
            PG8_BAR; PG8_WAIT_L(0); PG8_MMA(0, 1, At, B1); PG8_BAR;
            PG8_LDA(At, 0, 1); PG8_STAGE(PG8_SA(0, 0), a2, voffA);
            PG8_BAR; PG8_WAIT_L(0); PG8_MMA(1, 0, At, B0); PG8_BAR; PG8_SCHED;
            PG8_STAGE(PG8_SB(0, 1), b2 + hstep, voffB);
            PG8_WAIT_V(6); PG8_BAR; PG8_MMA(1, 1, At, B1); PG8_BAR;
            PG8_LDB(B0, 1, 0); PG8_SCHED; PG8_LDA(At, 1, 0); PG8_STAGE(PG8_SA(0, 1), a2 + hstep, voffA);
            PG8_WAIT_L(8); PG8_BAR; PG8_WAIT_L(0); PG8_MMA(0, 0, At, B0); PG8_BAR; PG8_SCHED;
            PG8_LDB(B1, 1, 1); PG8_STAGE(PG8_SB(1, 0), b3, voffB);
            PG8_BAR; PG8_WAIT_L(0); PG8_MMA(0, 1, At, B1); PG8_BAR;
            PG8_LDA(At, 1, 1); PG8_STAGE(PG8_SA(1, 0), a3, voffA);
            PG8_BAR; PG8_WAIT_L(0); PG8_MMA(1, 0, At, B0); PG8_BAR; PG8_SCHED;
            PG8_STAGE(PG8_SB(1, 1), b3 + hstep, voffB);
            PG8_WAIT_V(6); PG8_BAR; PG8_MMA(1, 1, At, B1); PG8_BAR;
            }
        }
        if constexpr (ALIGN_EPI) { if (wr == 0) PG8_BAR; }
        if constexpr (!Epi::AFTER_DRAIN) { E(acc, cur, wr, wc, fr, fq); S.done(cur); }
        if (!has_next) break;
#pragma unroll
        for (int a = 0; a < 2; ++a)
#pragma unroll
            for (int b = 0; b < 2; ++b)
#pragma unroll
                for (int m = 0; m < 4; ++m)
#pragma unroll
                    for (int n = 0; n < 2; ++n) acc[a][b][m][n] = (f32x4){0.f, 0.f, 0.f, 0.f};
        cur = nxt; cA = nA; cB = nB; ++ui;
        if constexpr (ALIGN_EPI) { if (wr == 1) PG8_BAR; }
    }
    PG8_WAIT_V(0);
    if constexpr (!ALIGN_EPI) { if (wr == 0) PG8_BAR; }
    PG8_BAR;
#undef PG8_SA
#undef PG8_SB
#undef PG8_STAGE
#undef PG8_LDA
#undef PG8_LDB
#undef PG8_MMA
#undef PG8_WAIT_V
#undef PG8_WAIT_L
#undef PG8_BAR
#undef PG8_SCHED
}
}
#endif

#ifndef EMU
#define LAS __attribute__((address_space(3)))
#define XB_TMO      128
#define XB_XCNT(j)  (256  + 64 * (j))
#define XB_XSUB(j)  (1280 + 64 * (j))
#define XB_XGEN(j)  (2304 + 64 * (j))
#define XB_TOP      3328
#define XB_TOPGEN   3392
#define XCD_BAR_WORDS 3456
#define XB_SPIN_CAP (1u << 18)
__device__ __forceinline__ unsigned xb_ld(unsigned* p)              { return __hip_atomic_load(p, __ATOMIC_RELAXED, __HIP_MEMORY_SCOPE_AGENT); }
__device__ __forceinline__ unsigned xb_add(unsigned* p, unsigned v) { return __hip_atomic_fetch_add(p, v, __ATOMIC_RELAXED, __HIP_MEMORY_SCOPE_AGENT); }
__device__ __forceinline__ unsigned xb_xcc_id() { return (unsigned)__builtin_amdgcn_s_getreg((3 << 11) | 20) & 0xFu; }
#define XB_SPIN(cond, bar) do { unsigned _sp = 0; while (cond) { __builtin_amdgcn_s_sleep(1); \
    if ((++_sp & 255u) == 0u) { if (xb_ld(&(bar)[XB_TMO])) break; if (_sp > XB_SPIN_CAP) { atomicAdd(&(bar)[XB_TMO], 1u); break; } } } } while (0)
struct XcdBarrier { unsigned* bar; unsigned x; volatile LAS unsigned* st; };
__device__ __forceinline__ XcdBarrier xcd_barrier_post(unsigned* bar, volatile LAS unsigned* st) {
    XcdBarrier b; b.bar = bar; b.x = xb_xcc_id(); b.st = st;
    if (threadIdx.x == 0) (void)xb_add(&bar[XB_XCNT(b.x)], 1u);
    return b;
}
__device__ __forceinline__ void xcd_barrier_complete(unsigned* bar, unsigned x, unsigned& nloc, unsigned& nx) {
    const unsigned G = gridDim.x * gridDim.y * gridDim.z;
    unsigned sum, cnt, mine, sp = 0u;
    for (;;) {
        sum = 0u; cnt = 0u; mine = 0u;
#pragma unroll
        for (unsigned j = 0; j < 16; ++j) { const unsigned c = xb_ld(&bar[XB_XCNT(j)]); sum += c; cnt += (c > 0u) ? 1u : 0u; mine = (j == x) ? c : mine; }
        if (sum == G) break;
        __builtin_amdgcn_s_sleep(1);
        if ((++sp & 255u) == 0u) { if (xb_ld(&bar[XB_TMO])) break; if (sp > XB_SPIN_CAP) { atomicAdd(&bar[XB_TMO], 1u); break; } }
    }
    nloc = mine > 0u ? mine : 1u; nx = cnt > 0u ? cnt : 1u;
}
__device__ __forceinline__ void xcd_barrier(const XcdBarrier& b) {
    asm volatile("s_waitcnt vmcnt(0)" ::: "memory");
    __syncthreads();
    if (threadIdx.x == 0) {
        unsigned* bar = b.bar;
        __builtin_amdgcn_s_waitcnt(0);
        unsigned nloc = b.st[0], nx = b.st[1];
        if (nloc == 0u) { xcd_barrier_complete(bar, b.x, nloc, nx); b.st[0] = nloc; b.st[1] = nx; }
        const unsigned old = xb_add(&bar[XB_XSUB(b.x)], 1u);
        const unsigned gen = old / nloc;
        if (old + 1u == (gen + 1u) * nloc) {
            __builtin_amdgcn_fence(__ATOMIC_RELEASE, "agent");
            asm volatile("s_waitcnt vmcnt(0)" ::: "memory");
            const unsigned og = xb_add(&bar[XB_TOP], 1u);
            const unsigned tg = og / nx;
            if (og + 1u == (tg + 1u) * nx) xb_add(&bar[XB_TOPGEN], 1u);
            else XB_SPIN(xb_ld(&bar[XB_TOPGEN]) == tg, bar);
            __builtin_amdgcn_fence(__ATOMIC_ACQUIRE, "agent");
            xb_add(&bar[XB_XGEN(b.x)], 1u);
            asm volatile("s_waitcnt vmcnt(0)" ::: "memory");
        } else {
            XB_SPIN(xb_ld(&bar[XB_XGEN(b.x)]) == gen, bar);
            __builtin_amdgcn_fence(__ATOMIC_ACQUIRE, "agent");
            asm volatile("s_waitcnt vmcnt(0)" ::: "memory");
        }
    }
    __syncthreads();
}
constexpr int RING_BYTES = 131072, MISC_OFF = RING_BYTES + 320, LDS_BYTES = 147456;
constexpr int CW_BAR = 4096;
#endif

#ifndef PHASE_MASK
#define PHASE_MASK 0xFFFF
#endif
#define PM(k) ((PHASE_MASK >> (k)) & 1)
#ifdef EMU
typedef const Params* ArgPtr;
DEV Params load_params(ArgPtr a) { return *a; }
#else
struct Args { Params p; int ph_lo, ph_hi, li, pad; };
typedef const __attribute__((address_space(4))) Args* ArgPtr;
DEV Params load_params(ArgPtr ap) { Params p;
#pragma unroll
    for (int i = 0; i < 22; ++i) p.in[i] = ap->p.in[i];
    p.out = ap->p.out; p.ws = ap->p.ws; return p; }
#endif
#ifndef PROBE_DUP
#define PROBE_DUP 0
#endif
DEV void run_one_phase(ArgPtr ap, int ph, bool dry) {
    if (ph == 0) { if (PM(0)) { const Params p = load_params(ap); phase_prologue(p); } return; }
    const int l = (ph - PH_L0) / PH_PER_LAYER, r = (ph - PH_L0) % PH_PER_LAYER;
    if (PM(1) && (r == 0 || r == 9)) {
        const Params p = load_params(ap);
        const int f = (r == 9) ? 1 : 0;
#ifdef EMU
        emu_gemm_up(p, l, f);
#else
        pg8::Gemm g{(const pg8::bf16_t*)(p.ws + WS_XB), W13T(p, l, f), M, 2 * DFF, D}; pg8::StaticOrder S; S.init(M, 2 * DFF, nblk(), bid());
        pg8::EpiSwiGLU E{(pg8::bf16_t*)(p.ws + WS_HZ)};
        pg8::gemm_phase<pg8::EpiSwiGLU, pg8::StaticOrder, true, true>((PG8_LAS unsigned char*)dyn_lds, g, S, E);
#endif
    } else if (PM(2) && (r == 1 || r == 10 || r == 7)) {
        const Params p = load_params(ap);
        const int f = (r == 10) ? 1 : 0;
        const unsigned short* A = (r == 7) ? (const unsigned short*)(p.ws + WS_XB) : (const unsigned short*)(p.ws + WS_HZ);
        const unsigned short* Bt = (r == 7) ? WOUTT(p, l) : W2T(p, l, f);
        const int K = (r == 7) ? D : DFF;
        const float* base = (l == 0 && r == 1) ? p.in[0] : p.out;
        const float coef = dry ? 0.0f : ((r == 7) ? 1.0f : 0.5f);
#ifdef EMU
        emu_gemm_resid(p, A, Bt, K, base, ALPHA, coef);
#else
        pg8::Gemm g{A, Bt, M, D, K}; pg8::StaticOrder S; S.init(M, D, nblk(), bid());
        pg8::EpiResid E{dry ? p.out : base, p.out, dry ? 1.0f : ALPHA, coef};
        pg8::gemm_phase<pg8::EpiResid, pg8::StaticOrder, true, true>((PG8_LAS unsigned char*)dyn_lds, g, S, E);
#endif
    } else if (PM(3) && (r == 2 || r == 8 || r == 11)) {
        const Params p = load_params(ap);
        phase_ln(p, l, r == 2 ? 0 : (r == 8 ? 1 : 2));
    } else if (PM(4) && r == 3) {
        const Params p = load_params(ap);
#ifdef EMU
        emu_gemm_z(p, l);
#else
        pg8::Gemm g{(const pg8::bf16_t*)(p.ws + WS_XB), WINT(p, l), M, NINP, D}; pg8::StaticOrder S; S.init(M, NINP, nblk(), bid());
        pg8::EpiZ E{(pg8::bf16_t*)(p.ws + WS_HZ), (float*)(p.ws + WS_GF)};
        pg8::gemm_phase<pg8::EpiZ, pg8::StaticOrder, true, true>((PG8_LAS unsigned char*)dyn_lds, g, S, E);
#endif
    } else if (PM(5) && r == 4) { const Params p = load_params(ap); phase_m1(p, l); }
    else if (PM(6) && r == 5) { const Params p = load_params(ap); phase_m1b(p); }
    else if (PM(7) && r == 6) { const Params p = load_params(ap); phase_m2(p, l); }
}

#ifdef EMU
static void run_phases(const Params& p, int lo, int hi) { for (int ph = lo; ph < hi; ++ph) run_one_phase(&p, ph, false); }
#else
__global__ void __launch_bounds__(512, 2) mega_fwd(Args a) {
    volatile LAS unsigned* MISC = (volatile LAS unsigned*)((LAS unsigned char*)dyn_lds + MISC_OFF);
    for (int u = threadIdx.x; u < (LDS_BYTES - RING_BYTES) / 4; u += 512) ((LAS unsigned*)((LAS unsigned char*)dyn_lds + RING_BYTES))[u] = 0u;
    __syncthreads();
    unsigned* barw = (unsigned*)(a.p.ws) + CW_BAR + a.li * XCD_BAR_WORDS;
    XcdBarrier bar; bar.bar = barw; bar.x = 0; bar.st = nullptr;
    if (a.ph_hi - a.ph_lo > 1) bar = xcd_barrier_post(barw, MISC + 8);
    const int ph_lo = a.ph_lo, ph_hi = a.ph_hi;
    for (int ph = ph_lo; ph < ph_hi; ++ph) {
        ArgPtr ap = (ArgPtr)__builtin_amdgcn_kernarg_segment_ptr();
        asm volatile("" : "+s"(ap));
        run_one_phase(ap, ph, false);
#if PROBE_DUP
        { const int r = (ph - PH_L0) % PH_PER_LAYER;
          const int kind = ph == 0 ? 0 : ((r == 0 || r == 9) ? 1 : (r == 1 || r == 10 || r == 7) ? 2 : (r == 2 || r == 8 || r == 11) ? 3 : r == 3 ? 4 : r == 4 ? 5 : r == 5 ? 6 : 7);
          if ((PROBE_DUP >> kind) & 1) { xcd_barrier(bar); run_one_phase(ap, ph, true); }
          if ((PROBE_DUP >> 8) & 1) { if (ph + 1 < ph_hi) xcd_barrier(bar); } }
#endif
        if (ph + 1 < ph_hi) xcd_barrier(bar);
    }
}

extern "C" void kernel_launch(void* const* d_in, const int* in_sizes, int n_in, void* d_out, int out_size, void* d_ws, size_t ws_size, hipStream_t stream) {
    static int grid = 0;
    if (grid == 0) {
        if (n_in != 22 || in_sizes[0] != M * D || out_size != M * D || ws_size < WS_TOTAL) { fprintf(stderr, "kernel_launch: unexpected shapes (n_in %d, in0 %d, out %d, ws %zu < %zu)\n", n_in, n_in > 0 ? in_sizes[0] : -1, out_size, ws_size, (size_t)WS_TOTAL); grid = -1; return; }
        int dev = 0, cus = 0, per_cu = 0;
        if (hipGetDevice(&dev) != hipSuccess || hipDeviceGetAttribute(&cus, hipDeviceAttributeMultiprocessorCount, dev) != hipSuccess) { grid = -1; return; }
        if (hipFuncSetAttribute((const void*)mega_fwd, hipFuncAttributeMaxDynamicSharedMemorySize, LDS_BYTES) != hipSuccess) { fprintf(stderr, "kernel_launch: hipFuncSetAttribute failed\n"); grid = -1; return; }
        if (hipOccupancyMaxActiveBlocksPerMultiprocessor(&per_cu, (const void*)mega_fwd, 512, LDS_BYTES) != hipSuccess || per_cu < 1) fprintf(stderr, "kernel_launch: occupancy query reports %d blocks per CU\n", per_cu);
        (void)hipGetLastError();
        grid = cus;
    }
    if (grid < 0) return;
    if (hipMemsetAsync(d_ws, 0, CTL_BYTES, stream) != hipSuccess) return;
    Args a{};
    for (int i = 0; i < 22; ++i) a.p.in[i] = (const float*)d_in[i];
    a.p.out = (float*)d_out; a.p.ws = (unsigned char*)d_ws;
#if MK_N_LAUNCHES == 1
    a.ph_lo = 0; a.ph_hi = NPHASES; a.li = 0;
    hipLaunchKernelGGL(mega_fwd, dim3(grid), dim3(512), LDS_BYTES, stream, a);
#else
    for (int ph = 0; ph < NPHASES; ++ph) { a.ph_lo = ph; a.ph_hi = ph + 1; a.li = 0; hipLaunchKernelGGL(mega_fwd, dim3(grid), dim3(512), LDS_BYTES, stream, a); }
#endif
}
#endif
```
